# Optimizing an MI355X kernel written in HIP

```python
import jax
import jax.numpy as jnp
from jax import lax
import numpy as np

D_MODEL = 1024
BATCH = 2
SEQ = 8192
DEPTH = 4

GRID_W = 64
CTX_LEN = 256
RET_HEADS = 4
RET_DK = 64
RET_DV = 128
RET_CHUNK = 128
RET_QK_W = RET_HEADS * RET_DK
RET_V_W = RET_HEADS * RET_DV
NA_HEADS = 8
NA_DH = 64
NA_KH = 8
NA_KW = 16
NA_W = NA_HEADS * NA_DH
MLA_HEADS = 8
MLA_Q_RANK = 256
MLA_KV_RANK = 256
MLA_NOPE = 64
MLA_ROPE = 32
MLA_DV = 64
MLA_V_W = MLA_HEADS * MLA_DV
D_FF = 4 * D_MODEL
ROPE_BASE = 10000.0
Q_BLOCK = 128
EPS = 1e-5
DEEPNORM_ALPHA = (2 * DEPTH) ** 0.25
DEEPNORM_BETA = (8 * DEPTH) ** -0.25
IN_SPLITS = (RET_QK_W, RET_QK_W, RET_V_W, RET_V_W, RET_V_W, NA_W, NA_W, NA_W,
             MLA_Q_RANK, MLA_KV_RANK, MLA_ROPE, D_MODEL, D_MODEL, D_MODEL)
IN_WIDTH = sum(IN_SPLITS)

kernel_name = 'hybrid_retention_natten_mla_dit_block'


def layer_norm(x, gain, bias):
    xf = x.astype(jnp.float32)
    mu = jnp.mean(xf, axis=-1, keepdims=True)
    var = jnp.mean(jnp.square(xf - mu), axis=-1, keepdims=True)
    return ((xf - mu) * lax.rsqrt(var + EPS) * gain + bias).astype(x.dtype)


def rms_norm(x, gain):
    xf = x.astype(jnp.float32)
    return (xf * lax.rsqrt(jnp.mean(jnp.square(xf), axis=-1, keepdims=True) + EPS) * gain).astype(x.dtype)


def to_heads(a, n_heads):
    b, t, _ = a.shape
    return a.reshape(b, t, n_heads, -1).transpose(0, 2, 1, 3)


def merge_heads(a):
    b, h, t, d = a.shape
    return a.transpose(0, 2, 1, 3).reshape(b, t, h * d)


def axial_rope(n_tok, rot_dim):
    t = jnp.arange(n_tok)
    row = (t // GRID_W).astype(jnp.float32)
    col = (t % GRID_W).astype(jnp.float32)
    n_freq = rot_dim // 4
    inv_freq = ROPE_BASE ** (-2.0 * jnp.arange(n_freq, dtype=jnp.float32) / (rot_dim // 2))
    ang = jnp.concatenate([row[:, None] * inv_freq, col[:, None] * inv_freq], axis=-1)
    return jnp.cos(ang), jnp.sin(ang)


def apply_rope(x, rope):
    cos, sin = rope
    shape = (1, cos.shape[0]) + (1,) * (x.ndim - 3) + (cos.shape[1],)
    cos = cos.reshape(shape).astype(x.dtype)
    sin = sin.reshape(shape).astype(x.dtype)
    x1, x2 = jnp.split(x, 2, axis=-1)
    return jnp.concatenate([x1 * cos - x2 * sin, x1 * sin + x2 * cos], axis=-1)


def attend_blocks(q, k, v):
    b, h, t, d = q.shape
    nb = t // Q_BLOCK
    qb = jnp.moveaxis(q.reshape(b, h, nb, Q_BLOCK, d), 2, 0)

    def one_block(qi):
        s = jnp.einsum('bhqd,bhkd->bhqk', qi, k).astype(jnp.float32)
        p = jax.nn.softmax(s, axis=-1).astype(v.dtype)
        return jnp.einsum('bhqk,bhkv->bhqv', p, v)

    o = lax.map(one_block, qb)
    return jnp.moveaxis(o, 0, 2).reshape(b, h, t, v.shape[-1])


def retention_chunkwise(q, k, v, log_gamma, s0):
    b, h, t, dk = q.shape
    dv = v.shape[-1]
    n = t // RET_CHUNK
    qc = q.reshape(b, h, n, RET_CHUNK, dk)
    kc = k.reshape(b, h, n, RET_CHUNK, dk)
    vc = v.reshape(b, h, n, RET_CHUNK, dv)
    pos = jnp.arange(RET_CHUNK, dtype=jnp.float32)
    lg = log_gamma[:, None]
    diff = pos[:, None] - pos[None, :]
    decay_mat = jnp.where(diff >= 0, jnp.exp(lg[:, :, None] * jnp.maximum(diff, 0.0)), 0.0)
    q_decay = jnp.exp(lg * (pos + 1.0))
    k_decay = jnp.exp(lg * (RET_CHUNK - 1.0 - pos))
    chunk_decay = jnp.exp(log_gamma * RET_CHUNK)
    scores = jnp.einsum('bhncd,bhnsd->bhncs', qc, kc) * decay_mat[None, :, None]
    inner = jnp.einsum('bhncs,bhnsv->bhncv', scores, vc)
    kv_chunk = jnp.einsum('bhnsd,bhnsv->nbhdv', kc * k_decay[None, :, None, :, None], vc)

    def step(s, kv):
        return s * chunk_decay[None, :, None, None] + kv, s

    s_final, s_prev = lax.scan(step, s0, kv_chunk)
    cross = jnp.einsum('bhncd,nbhdv->bhncv', qc * q_decay[None, :, None, :, None], s_prev)
    return (inner + cross).reshape(b, h, t, dv), s_final


def retention_final_state(k, v, log_gamma):
    t = k.shape[2]
    w = jnp.exp(log_gamma[:, None] * (t - 1.0 - jnp.arange(t, dtype=jnp.float32)))
    return jnp.einsum('bhtd,bhtv->bhdv', k * w[None, :, :, None], v)


def head_group_norm(o, gain):
    of = o.astype(jnp.float32)
    mu = jnp.mean(of, axis=-1, keepdims=True)
    var = jnp.mean(jnp.square(of - mu), axis=-1, keepdims=True)
    return merge_heads((of - mu) * lax.rsqrt(var + EPS)) * gain


def retention_qkv(pq, pk, pv, rope):
    b, t, _ = pq.shape
    q = pq.reshape(b, t, RET_HEADS, RET_DK)
    k = pk.reshape(b, t, RET_HEADS, RET_DK) * (RET_DK ** -0.5)
    if rope is not None:
        q = apply_rope(q, rope)
        k = apply_rope(k, rope)
    return q.transpose(0, 2, 1, 3), k.transpose(0, 2, 1, 3), to_heads(pv, RET_HEADS)


def retention_branch(parts_x, parts_z, p, rope, need_ctx):
    log_gamma = jnp.log1p(-jnp.exp(p['ret_log_decay'].astype(jnp.float32)))
    qx, kx, vx = retention_qkv(parts_x[0], parts_x[1], parts_x[2], rope)
    qz, kz, vz = retention_qkv(parts_z[0], parts_z[1], parts_z[2], None)
    s_zero = jnp.zeros((qx.shape[0], RET_HEADS, RET_DK, RET_DV), jnp.float32)
    out_x, out_z = [], []
    for d in range(2):
        f = (lambda a: a) if d == 0 else (lambda a: jnp.flip(a, axis=2))
        if need_ctx:
            o_z, s_ctx = retention_chunkwise(f(qz), f(kz), f(vz), log_gamma[d], s_zero)
            out_z.append(f(o_z))
        else:
            s_ctx = retention_final_state(f(kz), f(vz), log_gamma[d])
        o_x, _ = retention_chunkwise(f(qx), f(kx), f(vx), log_gamma[d], s_ctx)
        out_x.append(f(o_x))

    def gated(outs, g_fwd, g_bwd):
        return (jax.nn.silu(g_fwd) * head_group_norm(outs[0], p['ret_gn_gain'])
                + jax.nn.silu(g_bwd) * head_group_norm(outs[1], p['ret_gn_gain']))

    y_x = gated(out_x, parts_x[3], parts_x[4])
    y_z = gated(out_z, parts_z[3], parts_z[4]) if need_ctx else None
    return y_x, y_z


def neighborhood_attention(q, k, v, k_ctx, v_ctx, rpb):
    b, h, t, d = q.shape
    rows = t // GRID_W
    kh = min(NA_KH, rows)
    kg = k.reshape(b, h, rows, GRID_W, d)
    vg = v.reshape(b, h, rows, GRID_W, d)
    qg = jnp.moveaxis(q.reshape(b, h, rows, GRID_W, d), 2, 0)
    cols = np.arange(GRID_W)
    col_start = np.clip(cols - NA_KW // 2, 0, GRID_W - NA_KW)
    col_idx = col_start[:, None] + np.arange(NA_KW)[None, :]
    dc_idx = col_idx - cols[:, None] + (NA_KW - 1)
    n_loc = kh * NA_KW

    def one_row(args):
        r, q_row = args
        r0 = jnp.clip(r - kh // 2, 0, rows - kh)
        k_rows = lax.dynamic_slice_in_dim(kg, r0, kh, axis=2)
        v_rows = lax.dynamic_slice_in_dim(vg, r0, kh, axis=2)
        k_win = k_rows[:, :, :, col_idx]
        v_win = v_rows[:, :, :, col_idx]
        dr_idx = r0 + jnp.arange(kh) - r + (NA_KH - 1)
        bias = rpb[:, dr_idx[:, None, None], dc_idx[None, :, :]]
        s_loc = jnp.einsum('bhwd,bhawkd->bhwak', q_row, k_win) + jnp.transpose(bias, (0, 2, 1, 3))[None]
        s_loc = s_loc.reshape(b, h, GRID_W, n_loc)
        s_ctx = jnp.einsum('bhwd,bhld->bhwl', q_row, k_ctx)
        s_all = jnp.concatenate([s_loc.astype(jnp.float32), s_ctx.astype(jnp.float32)], axis=-1)
        prob = jax.nn.softmax(s_all, axis=-1).astype(v.dtype)
        p_loc = prob[..., :n_loc].reshape(b, h, GRID_W, kh, NA_KW)
        p_ctx = prob[..., n_loc:]
        return (jnp.einsum('bhwak,bhawkv->bhwv', p_loc, v_win)
                + jnp.einsum('bhwl,bhlv->bhwv', p_ctx, v_ctx))

    out = lax.map(one_row, (jnp.arange(rows), qg))
    return jnp.moveaxis(out, 0, 2).reshape(b, h, t, d)


def na_branch(parts_x, parts_z, p, need_ctx):
    scale = NA_DH ** -0.5
    qx, kx, vx = [to_heads(a, NA_HEADS) for a in parts_x]
    qz, kz, vz = [to_heads(a, NA_HEADS) for a in parts_z]
    y_x = merge_heads(neighborhood_attention(qx * scale, kx, vx, kz, vz, p['na_rpb']))
    y_z = merge_heads(attend_blocks(qz * scale, kz, vz)) if need_ctx else None
    return y_x, y_z


def mla_project(pq, pkv, pkr, p, rope):
    b, t, _ = pq.shape
    q = (rms_norm(pq, p['mla_q_norm']) @ p['mla_w_qup']).reshape(b, t, MLA_HEADS, MLA_NOPE + MLA_ROPE)
    kv = (rms_norm(pkv, p['mla_kv_norm']) @ p['mla_w_kvup']).reshape(b, t, MLA_HEADS, MLA_NOPE + MLA_DV)
    q_nope, q_rope = q[..., :MLA_NOPE], q[..., MLA_NOPE:]
    k_nope, v = kv[..., :MLA_NOPE], kv[..., MLA_NOPE:]
    k_rope = pkr
    if rope is not None:
        q_rope = apply_rope(q_rope, rope)
        k_rope = apply_rope(k_rope, rope)
    q = jnp.concatenate([q_nope, q_rope], axis=-1) * ((MLA_NOPE + MLA_ROPE) ** -0.5)
    k = jnp.concatenate([k_nope, jnp.broadcast_to(k_rope[:, :, None, :], (b, t, MLA_HEADS, MLA_ROPE))], axis=-1)
    return q.transpose(0, 2, 1, 3), k.transpose(0, 2, 1, 3), v.transpose(0, 2, 1, 3)


def mla_branch(parts_x, parts_z, p, rope, need_ctx):
    qx, kx, vx = mla_project(parts_x[0], parts_x[1], parts_x[2], p, rope)
    qz, kz, vz = mla_project(parts_z[0], parts_z[1], parts_z[2], p, None)
    k_all = jnp.concatenate([kx, kz], axis=2)
    v_all = jnp.concatenate([vx, vz], axis=2)
    y_x = merge_heads(attend_blocks(qx, k_all, v_all))
    y_z = merge_heads(attend_blocks(qz, kz, vz)) if need_ctx else None
    return y_x, y_z


def token_mixers(hx, hz, p, rope_ret, rope_mla, need_ctx):
    offsets = np.cumsum(IN_SPLITS)[:-1].tolist()
    px = jnp.split(hx @ p['w_in'], offsets, axis=-1)
    pz = jnp.split(hz @ p['w_in'], offsets, axis=-1)
    ya_x, ya_z = retention_branch(px[0:5], pz[0:5], p, rope_ret, need_ctx)
    yb_x, yb_z = na_branch(px[5:8], pz[5:8], p, need_ctx)
    yc_x, yc_z = mla_branch(px[8:11], pz[8:11], p, rope_mla, need_ctx)

    def merge(parts, ya, yb, yc):
        y = (jax.nn.sigmoid(parts[11]) * (ya @ p['w_branch_ret'])
             + jax.nn.sigmoid(parts[12]) * (yb @ p['w_branch_na'])
             + jax.nn.sigmoid(parts[13]) * (yc @ p['w_branch_mla']))
        return y @ p['w_out']

    mix_x = merge(px, ya_x, yb_x, yc_x)
    mix_z = merge(pz, ya_z, yb_z, yc_z) if need_ctx else None
    return mix_x, mix_z


def sq_relu_mlp(h, p):
    return jnp.square(jax.nn.relu(h @ p['w_ff1'])) @ p['w_ff2']


def hybrid_layer(x, z, c, c_ctx, p, rope_ret, rope_mla, need_ctx):
    mod_x = jax.nn.silu(c) @ p['w_ada'] + p['b_ada']
    mod_z = jax.nn.silu(c_ctx) @ p['w_ada'] + p['b_ada']
    sh1x, sc1x, g1x, sh2x, sc2x, g2x = [m[:, None, :] for m in jnp.split(mod_x, 6, axis=-1)]
    sh1z, sc1z, g1z, sh2z, sc2z, g2z = jnp.split(mod_z, 6, axis=-1)
    hx = x * (1.0 + sc1x) + sh1x
    hz = z * (1.0 + sc1z) + sh1z
    mix_x, mix_z = token_mixers(hx, hz, p, rope_ret, rope_mla, need_ctx)
    x = layer_norm(DEEPNORM_ALPHA * x + g1x * mix_x, p['ln_gain'][0], p['ln_bias'][0])
    x = layer_norm(DEEPNORM_ALPHA * x + g2x * sq_relu_mlp(x * (1.0 + sc2x) + sh2x, p),
                   p['ln_gain'][1], p['ln_bias'][1])
    if need_ctx:
        z = layer_norm(DEEPNORM_ALPHA * z + g1z * mix_z, p['ln_gain'][0], p['ln_bias'][0])
        z = layer_norm(DEEPNORM_ALPHA * z + g2z * sq_relu_mlp(z * (1.0 + sc2z) + sh2z, p),
                       p['ln_gain'][1], p['ln_bias'][1])
    else:
        z = None
    return x, z


def setup_inputs(seed: int = 0) -> dict:
    key = jax.random.key(seed)
    ks = jax.random.split(key, 24)
    f32 = jnp.float32
    L = DEPTH
    D = D_MODEL

    def nrm(k, shape, s):
        return s * jax.random.normal(k, shape, f32)

    base_decay = -(5.0 + jnp.arange(RET_HEADS, dtype=f32)) * float(np.log(2.0))
    return {
        'x': nrm(ks[0], (BATCH, SEQ, D), 1.0),
        'c': nrm(ks[1], (BATCH, D), 1.0),
        'ctx': nrm(ks[2], (BATCH, CTX_LEN, D), 1.0),
        'c_ctx': nrm(ks[3], (D,), 1.0),
        'w_ada': nrm(ks[4], (L, D, 6 * D), 0.5 * D ** -0.5),
        'b_ada': nrm(ks[5], (L, 6 * D), 0.01),
        'w_in': nrm(ks[6], (L, D, IN_WIDTH), D ** -0.5),
        'ret_log_decay': base_decay + nrm(ks[7], (L, 2, RET_HEADS), 0.1),
        'ret_gn_gain': 1.0 + nrm(ks[8], (L, RET_V_W), 0.02),
        'na_rpb': nrm(ks[9], (L, NA_HEADS, 2 * NA_KH - 1, 2 * NA_KW - 1), 0.1),
        'mla_q_norm': 1.0 + nrm(ks[10], (L, MLA_Q_RANK), 0.02),
        'mla_w_qup': nrm(ks[11], (L, MLA_Q_RANK, MLA_HEADS * (MLA_NOPE + MLA_ROPE)), MLA_Q_RANK ** -0.5),
        'mla_kv_norm': 1.0 + nrm(ks[12], (L, MLA_KV_RANK), 0.02),
        'mla_w_kvup': nrm(ks[13], (L, MLA_KV_RANK, MLA_HEADS * (MLA_NOPE + MLA_DV)), MLA_KV_RANK ** -0.5),
        'w_branch_ret': nrm(ks[14], (L, RET_V_W, D), DEEPNORM_BETA * RET_V_W ** -0.5),
        'w_branch_na': nrm(ks[15], (L, NA_W, D), DEEPNORM_BETA * NA_W ** -0.5),
        'w_branch_mla': nrm(ks[16], (L, MLA_V_W, D), DEEPNORM_BETA * MLA_V_W ** -0.5),
        'w_out': nrm(ks[17], (L, D, D), DEEPNORM_BETA * D ** -0.5),
        'w_ff1': nrm(ks[18], (L, D, D_FF), D ** -0.5),
        'w_ff2': nrm(ks[19], (L, D_FF, D), DEEPNORM_BETA * D_FF ** -0.5),
        'ln_gain': 1.0 + nrm(ks[20], (L, 2, D), 0.02),
        'ln_bias': nrm(ks[21], (L, 2, D), 0.01),
    }


def reference(x, c, ctx, c_ctx, w_ada, b_ada, w_in, ret_log_decay, ret_gn_gain, na_rpb,
              mla_q_norm, mla_w_qup, mla_kv_norm, mla_w_kvup, w_branch_ret, w_branch_na,
              w_branch_mla, w_out, w_ff1, w_ff2, ln_gain, ln_bias):
    n_tok = x.shape[1]
    rope_ret = axial_rope(n_tok, RET_DK)
    rope_mla = axial_rope(n_tok, MLA_ROPE)
    z = ctx
    for l in range(DEPTH):
        p = {
            'w_ada': w_ada[l], 'b_ada': b_ada[l], 'w_in': w_in[l],
            'ret_log_decay': ret_log_decay[l], 'ret_gn_gain': ret_gn_gain[l], 'na_rpb': na_rpb[l],
            'mla_q_norm': mla_q_norm[l], 'mla_w_qup': mla_w_qup[l],
            'mla_kv_norm': mla_kv_norm[l], 'mla_w_kvup': mla_w_kvup[l],
            'w_branch_ret': w_branch_ret[l], 'w_branch_na': w_branch_na[l], 'w_branch_mla': w_branch_mla[l],
            'w_out': w_out[l], 'w_ff1': w_ff1[l], 'w_ff2': w_ff2[l],
            'ln_gain': ln_gain[l], 'ln_bias': ln_bias[l],
        }
        x, z = hybrid_layer(x, z, c, c_ctx, p, rope_ret, rope_mla, l < DEPTH - 1)
    return x
```

```cpp
#include <hip/hip_runtime.h>
#include <hip/hip_cooperative_groups.h>
#include <cstdio>
#include <cstdint>
namespace cg = cooperative_groups;

typedef unsigned short bf16_t;
typedef short bf16x8 __attribute__((ext_vector_type(8)));
typedef short s16x4 __attribute__((ext_vector_type(4)));
typedef float f32x4 __attribute__((ext_vector_type(4)));
#define AS3 __attribute__((address_space(3)))

constexpr int D = 1024, SEQ = 8192, CTX = 256, TB = SEQ + CTX, MROWS = 2 * TB;
constexpr int DEPTH = 4, INW = 7200, NP = 7296;
constexpr int NCHUNK = TB / 128;
constexpr int C_RQ = 0, C_RK = 256, C_RV = 512, C_GF = 1024, C_GB = 1536, C_NQ = 2048, C_NK = 2560, C_NV = 3072,
              C_MQD = 3584, C_MKVD = 3840, C_GATE = 4096, C_KR = 7168;
constexpr float LOG2E = 1.4426950408889634f;
constexpr float ALPHA = 1.681792830507429f;
constexpr float EPS = 1e-5f;

constexpr size_t SZ_P = (size_t)MROWS * NP * 2;
constexpr size_t WT_IN = 0, WT_QUP = WT_IN + (size_t)NP * 1024 * 2, WT_KVUP = WT_QUP + 768 * 256 * 2,
                 WT_BR = WT_KVUP + 1024 * 256 * 2, WT_OUT = WT_BR + 3 * (size_t)1024 * 512 * 2,
                 WT_FF1 = WT_OUT + (size_t)1024 * 1024 * 2, WT_FF2 = WT_FF1 + (size_t)4096 * 1024 * 2,
                 SZ_WT = WT_FF2 + (size_t)1024 * 4096 * 2;
constexpr size_t SZ_Z = (size_t)2 * CTX * D * 4;
constexpr size_t SZ_D = (size_t)MROWS * 1024 * 2;
constexpr size_t SZ_QM = (size_t)MROWS * 768 * 2, SZ_KVM = (size_t)MROWS * 1024 * 2;
constexpr size_t SZ_YC = (size_t)MROWS * 512 * 2;
constexpr size_t SZ_ST = (size_t)2 * 2 * 4 * NCHUNK * 8192 * 4;
constexpr size_t SZ_MOD = (size_t)DEPTH * 3 * 6144 * 4;
constexpr size_t SZ_TAB = (size_t)(2 * 128 * 16 + 2 * 128 * 8) * 4;
constexpr size_t OFF_P = 0, OFF_WT = OFF_P + SZ_P, OFF_Z = OFF_WT + SZ_WT, OFF_D = OFF_Z + SZ_Z, OFF_E = OFF_D + SZ_D,
                 OFF_YC = OFF_E + SZ_QM + SZ_KVM, OFF_ST = OFF_YC + SZ_YC, OFF_MOD = OFF_ST + SZ_ST, OFF_TAB = OFF_MOD + SZ_MOD,
                 OFF_BAR = OFF_TAB + SZ_TAB, WS_NEED = OFF_BAR + 16384;

constexpr int SMEM_BYTES = 65536 + 512;

struct Params {
  const float *x, *c, *ctx, *c_ctx, *w_ada, *b_ada, *w_in, *ret_log_decay, *ret_gn_gain, *na_rpb, *mla_q_norm, *mla_w_qup,
      *mla_kv_norm, *mla_w_kvup, *w_br_ret, *w_br_na, *w_br_mla, *w_out, *w_ff1, *w_ff2, *ln_gain, *ln_bias;
  float* out;
  char* ws;
};

typedef __bf16 bf2_t __attribute__((ext_vector_type(2)));
typedef float f2_t __attribute__((ext_vector_type(2)));
__device__ __forceinline__ bf16_t f2bf(float f) { return __builtin_bit_cast(unsigned short, (__bf16)f); }
__device__ __forceinline__ float bf2f(bf16_t h) { return __uint_as_float(((unsigned)h) << 16); }
__device__ __forceinline__ unsigned pack2(float lo, float hi) {
  f2_t v = {lo, hi};
  return __builtin_bit_cast(unsigned, __builtin_convertvector(v, bf2_t));
}
__device__ __forceinline__ float bflo(unsigned u) { return __uint_as_float(u << 16); }
__device__ __forceinline__ float bfhi(unsigned u) { return __uint_as_float(u & 0xffff0000u); }
__device__ __forceinline__ s16x4 tr_read(const bf16_t* p) { return __builtin_amdgcn_ds_read_tr16_b64_v4i16((AS3 s16x4*)p); }
__device__ __forceinline__ f32x4 mfma16(bf16x8 a, bf16x8 b, f32x4 c) { return __builtin_amdgcn_mfma_f32_16x16x32_bf16(a, b, c, 0, 0, 0); }
__device__ __forceinline__ char* WS(const Params& p) { size_t z = 0; asm volatile("" : "+s"(z)); return p.ws + z; }
__device__ __forceinline__ int tidx() { int t = threadIdx.x; asm volatile("" : "+v"(t)); return t; }
__device__ __forceinline__ float* xrow_ptr(const Params& p, int row) {
  int b = row / TB, t = row - b * TB;
  return t < CTX ? (float*)(WS(p) + OFF_Z) + (size_t)(b * CTX + t) * D : p.out + ((size_t)b * SEQ + (t - CTX)) * D;
}
__device__ __forceinline__ float fmax_nc(float a, float b) { return __builtin_amdgcn_fmed3f(a, b, __builtin_inff()); }
typedef unsigned u32x2_t __attribute__((ext_vector_type(2)));
__device__ __forceinline__ float xmax16(float x) {
  const u32x2_t r = __builtin_amdgcn_permlane16_swap(__float_as_uint(x), __float_as_uint(x), false, false);
  return __builtin_amdgcn_fmed3f(__uint_as_float(r[0]), __uint_as_float(r[1]), __builtin_inff());
}
__device__ __forceinline__ float xmax32(float x) {
  const u32x2_t r = __builtin_amdgcn_permlane32_swap(__float_as_uint(x), __float_as_uint(x), false, false);
  return __builtin_amdgcn_fmed3f(__uint_as_float(r[0]), __uint_as_float(r[1]), __builtin_inff());
}
__device__ __forceinline__ float dpp_f(float v, const int ctrl_sel) {
  unsigned u = __float_as_uint(v), r;
  if (ctrl_sel == 0) r = __builtin_amdgcn_update_dpp(0u, u, 0xB1, 0xf, 0xf, false);
  else if (ctrl_sel == 1) r = __builtin_amdgcn_update_dpp(0u, u, 0x4E, 0xf, 0xf, false);
  else if (ctrl_sel == 2) r = __builtin_amdgcn_update_dpp(0u, u, 0x141, 0xf, 0xf, false);
  else r = __builtin_amdgcn_update_dpp(0u, u, 0x140, 0xf, 0xf, false);
  return __uint_as_float(r);
}
__device__ __forceinline__ float wave_sum(float v) {
  v += dpp_f(v, 0);
  v += dpp_f(v, 1);
  v += dpp_f(v, 2);
  v += dpp_f(v, 3);
  { const u32x2_t r = __builtin_amdgcn_permlane16_swap(__float_as_uint(v), __float_as_uint(v), false, false); v = __uint_as_float(r[0]) + __uint_as_float(r[1]); }
  { const u32x2_t r = __builtin_amdgcn_permlane32_swap(__float_as_uint(v), __float_as_uint(v), false, false); v = __uint_as_float(r[0]) + __uint_as_float(r[1]); }
  return v;
}
__device__ __forceinline__ float xadd16(float v) { const u32x2_t r = __builtin_amdgcn_permlane16_swap(__float_as_uint(v), __float_as_uint(v), false, false); return __uint_as_float(r[0]) + __uint_as_float(r[1]); }
__device__ __forceinline__ float xadd32(float v) { const u32x2_t r = __builtin_amdgcn_permlane32_swap(__float_as_uint(v), __float_as_uint(v), false, false); return __uint_as_float(r[0]) + __uint_as_float(r[1]); }
__device__ __forceinline__ float half_sum32(float v) {
  v += dpp_f(v, 0); v += dpp_f(v, 1); v += dpp_f(v, 2); v += dpp_f(v, 3);
  return xadd16(v);
}
__device__ __forceinline__ float sigmoidf_(float v) { return __builtin_amdgcn_rcpf(1.f + __builtin_amdgcn_exp2f(-LOG2E * v)); }

struct GemmJob { const bf16_t* A; const bf16_t* Bt; int lda, ldb, K, brow, bcol, nm; };
template <int NM>
__device__ __forceinline__ void gemm_issue(const GemmJob& j, int t, int buf, char* smem, int tid) {
  const int cel = ((tid & 7) ^ ((tid >> 3) & 7)) * 8;
  const int r0 = tid >> 3;
  char* sb = smem + buf * 32768 + tid * 16;
  const bf16_t* pa = j.A + (size_t)(j.brow + r0) * j.lda + cel + t * 64;
  const bf16_t* pb = j.Bt + (size_t)(j.bcol + r0) * j.ldb + cel + t * 64;
  const size_t a32 = (size_t)32 * j.lda, b32 = (size_t)32 * j.ldb;
  if (NM == 4) {
#pragma unroll
    for (int i = 0; i < 4; ++i)
      __builtin_amdgcn_global_load_lds((const unsigned*)(pa + i * a32), (AS3 unsigned*)(sb + i * 4096), 16, 0, 0);
  } else {
    __builtin_amdgcn_global_load_lds((const unsigned*)pa, (AS3 unsigned*)sb, 16, 0, 0);
  }
#pragma unroll
  for (int i = 0; i < 4; ++i)
    __builtin_amdgcn_global_load_lds((const unsigned*)(pb + i * b32), (AS3 unsigned*)(sb + 16384 + i * 4096), 16, 0, 0);
}
__device__ __forceinline__ void gemm_prefetch0(const GemmJob& j, char* smem) {
  if (j.nm == 4) gemm_issue<4>(j, 0, 0, smem, tidx()); else gemm_issue<1>(j, 0, 0, smem, tidx());
}
template <int NM>
__device__ __forceinline__ void gemm_run(const GemmJob& j, char* smem, f32x4 (&acc)[NM][4]) {
  const int tid = tidx(), wid = tid >> 6, lane = tid & 63, wr = wid >> 1, wc = wid & 1, fr = lane & 15, fq = lane >> 4;
  const int foff0 = fr * 128 + ((fq ^ (fr & 7)) << 4);
  const int foff1 = fr * 128 + (((4 + fq) ^ (fr & 7)) << 4);
  const int nt = j.K >> 6;
#pragma unroll 1
  for (int t = 0; t < nt; ++t) {
    if (t + 1 < nt) {
      gemm_issue<NM>(j, t + 1, (t + 1) & 1, smem, tid);
      if (NM == 4) asm volatile("s_waitcnt vmcnt(8)" ::: "memory");
      else asm volatile("s_waitcnt vmcnt(5)" ::: "memory");
    } else {
      asm volatile("s_waitcnt vmcnt(0)" ::: "memory");
    }
    __builtin_amdgcn_s_barrier();
    const char* sA = smem + (t & 1) * 32768;
    const char* sB = sA + 16384;
    bf16x8 af[2][NM], bfr[2][4];
#pragma unroll
    for (int kh = 0; kh < 2; ++kh) {
      const int fo = kh ? foff1 : foff0;
#pragma unroll
      for (int n = 0; n < 4; ++n) bfr[kh][n] = *(const bf16x8*)(sB + (wc * 64 + n * 16) * 128 + fo);
#pragma unroll
      for (int m = 0; m < NM; ++m) af[kh][m] = *(const bf16x8*)(sA + (wr * 16 * NM + m * 16) * 128 + fo);
    }
    __builtin_amdgcn_sched_barrier(0);
#pragma unroll
    for (int kh = 0; kh < 2; ++kh)
#pragma unroll
      for (int m = 0; m < NM; ++m)
#pragma unroll
        for (int n = 0; n < 4; ++n) acc[m][n] = mfma16(bfr[kh][n], af[kh][m], acc[m][n]);
    __builtin_amdgcn_sched_barrier(0);
    asm volatile("s_waitcnt lgkmcnt(0)" ::: "memory");
    __builtin_amdgcn_s_barrier();
  }
}
template <int NM>
__device__ __forceinline__ void zero_acc(f32x4 (&acc)[NM][4]) {
#pragma unroll
  for (int m = 0; m < NM; ++m)
#pragma unroll
    for (int n = 0; n < 4; ++n) acc[m][n] = (f32x4){0.f, 0.f, 0.f, 0.f};
}
__device__ __forceinline__ void store4(bf16_t* dst, f32x4 v) {
  uint2 w; w.x = pack2(v[0], v[1]); w.y = pack2(v[2], v[3]);
  *(uint2*)dst = w;
}


template <int NM>
__device__ __forceinline__ void store_tile_lds(const f32x4 (&v)[NM][4], bf16_t* O, size_t ldo, int brow, int bcol, char* smem) {
  const int tid = tidx(), wid = tid >> 6, lane = tid & 63, wr = wid >> 1, wc = wid & 1, fr = lane & 15, fq = lane >> 4;
  char* C = smem + 32768;
#pragma unroll
  for (int m = 0; m < NM; ++m) {
    const int rl = wr * 16 * NM + m * 16 + fr;
#pragma unroll
    for (int n = 0; n < 4; ++n) {
      const int cc = wc * 8 + n * 2 + (fq >> 1);
      uint2 w; w.x = pack2(v[m][n][0], v[m][n][1]); w.y = pack2(v[m][n][2], v[m][n][3]);
      *(uint2*)(C + rl * 256 + ((cc ^ (rl & 15)) << 4) + ((fq & 1) << 3)) = w;
    }
  }
  asm volatile("s_waitcnt lgkmcnt(0)" ::: "memory");
  __builtin_amdgcn_s_barrier();
#pragma unroll
  for (int i = 0; i < 2 * NM; ++i) {
    const int id = tid + 256 * i, rl = id >> 4, c = id & 15;
    const uint4 w = *(const uint4*)(C + rl * 256 + ((c ^ (rl & 15)) << 4));
    *(uint4*)(O + (size_t)(brow + rl) * ldo + bcol + c * 8) = w;
  }
  asm volatile("s_waitcnt lgkmcnt(0)" ::: "memory");
  __builtin_amdgcn_s_barrier();
}

struct TileOrder {
  int nM, nN, x, npl, full, wlast, nmain, total, fine;
  __device__ __forceinline__ void init(int nM_, int nN_, int xcd, int fine_) {
    nM = nM_; nN = nN_; x = xcd; fine = fine_; npl = nM / 8; wlast = nN & 7; full = (nN >> 3) * npl * 8; nmain = npl * nN;
    const int nextra = (nM - npl * 8) * nN * (fine ? 4 : 1);
    total = nmain + (nextra + 7 - xcd) / 8;
  }
  __device__ __forceinline__ void get(int i, int& brow, int& pn, int& nm) const {
    nm = 4;
    if (i < full) { const int g = i / (npl * 8), r = i - g * (npl * 8); brow = ((r >> 3) * 8 + x) * 128; pn = g * 8 + (r & 7); }
    else if (i < nmain) { const int r = i - full; brow = ((r / wlast) * 8 + x) * 128; pn = (nN >> 3) * 8 + r % wlast; }
    else {
      const int e = (i - nmain) * 8 + x;
      if (fine) { brow = npl * 8 * 128 + (e / nN) * 32; nm = 1; } else brow = (npl * 8 + e / nN) * 128;
      pn = e % nN;
    }
  }
};


__device__ __forceinline__ GemmJob job_win(const Params& p, int pm, int pn) {
  GemmJob j; j.A = (const bf16_t*)(WS(p) + OFF_D); j.Bt = (const bf16_t*)(WS(p) + OFF_WT + WT_IN); j.lda = 1024; j.ldb = 1024; j.K = 1024;
  j.brow = pm * 128; j.bcol = pn * 128; j.nm = 4; return j;
}
__device__ __forceinline__ void tile_win(const Params& p, int pm, int pn, char* smem, const GemmJob next, const bool has_next) {
  const int tid = tidx(), wid = tid >> 6, lane = tid & 63, wr = wid >> 1, wc = wid & 1, fr = lane & 15, fq = lane >> 4;
  const bf16_t* Hx = (const bf16_t*)(WS(p) + OFF_D);
  const bf16_t* Wt = (const bf16_t*)(WS(p) + OFF_WT + WT_IN);
  bf16_t* P = (bf16_t*)(WS(p) + OFF_P);
  const float* T64c = (const float*)(WS(p) + OFF_TAB);
  const float* T64s = T64c + 128 * 16;
  const float* T32c = T64s + 128 * 16;
  const float* T32s = T32c + 128 * 8;
  f32x4 acc[4][4];
  zero_acc<4>(acc);
  const int brow = pm * 128, bcol = pn * 128;
  gemm_run<4>(job_win(p, pm, pn), smem, acc);
  const bool tabs = (bcol < 512) || (bcol == C_KR);
  if (has_next && !tabs) gemm_prefetch0(next, smem);
  const int cs = bcol + wc * 64;
#pragma unroll
  for (int m = 0; m < 4; ++m) {
    const int row = brow + wr * 64 + m * 16 + fr;
    const int t = row % TB;
    const bool isx = t >= CTX;
    const int pos = t - CTX, prow = pos >> 6, pcol = pos & 63;
    if (cs < 512) {
      if (isx) {
#pragma unroll
        for (int n = 0; n < 2; ++n) {
          const int pp = (n == 0) ? prow : pcol;
          const float4 cv4 = *(const float4*)(T64c + pp * 16 + fq * 4), sv4 = *(const float4*)(T64s + pp * 16 + fq * 4);
          const float cvv[4] = {cv4.x, cv4.y, cv4.z, cv4.w}, svv[4] = {sv4.x, sv4.y, sv4.z, sv4.w};
#pragma unroll
          for (int j = 0; j < 4; ++j) {
            const float cv = cvv[j], sv = svv[j];
            const float x1 = acc[m][n][j], x2 = acc[m][n + 2][j];
            acc[m][n][j] = x1 * cv - x2 * sv;
            acc[m][n + 2][j] = x1 * sv + x2 * cv;
          }
        }
      }
      if (cs >= 256) {
#pragma unroll
        for (int n = 0; n < 4; ++n) acc[m][n] = acc[m][n] * 0.125f;
      }
    } else if (cs >= C_NQ && cs < C_NQ + 512) {
#pragma unroll
      for (int n = 0; n < 4; ++n) acc[m][n] = acc[m][n] * (0.125f * LOG2E);
    } else if (cs == C_KR) {
      if (isx) {
        const int pp = (fq < 2) ? prow : pcol;
#pragma unroll
        for (int j = 0; j < 4; ++j) {
          const int f = (fq & 1) * 4 + j;
          const float cv = T32c[pp * 8 + f], sv = T32s[pp * 8 + f];
          const float x1 = acc[m][0][j], x2 = acc[m][1][j];
          acc[m][0][j] = x1 * cv - x2 * sv;
          acc[m][1][j] = x1 * sv + x2 * cv;
        }
      }
    }
  }
  if (has_next && tabs) { __builtin_amdgcn_sched_barrier(0); gemm_prefetch0(next, smem); }
  store_tile_lds<4>(acc, P, NP, brow, bcol, smem);
}

template <bool QUP>
__device__ __forceinline__ GemmJob job_up(const Params& p, int pm, int pn) {
  GemmJob j; j.A = (const bf16_t*)(WS(p) + OFF_P) + (QUP ? C_MQD : C_MKVD); j.Bt = (const bf16_t*)(WS(p) + OFF_WT + (QUP ? WT_QUP : WT_KVUP));
  j.lda = NP; j.ldb = 256; j.K = 256; j.brow = pm * 128; j.bcol = pn * 128; j.nm = 4; return j;
}
template <bool QUP>
__device__ __forceinline__ void tile_up(const Params& p, int pm, int pn, char* smem, const GemmJob next, const bool has_next) {
  const int tid = tidx(), wid = tid >> 6, lane = tid & 63, wr = wid >> 1, wc = wid & 1, fr = lane & 15, fq = lane >> 4;
  const bf16_t* P = (const bf16_t*)(WS(p) + OFF_P);
  const bf16_t* A = P + (QUP ? C_MQD : C_MKVD);
  const bf16_t* Wt = (const bf16_t*)(WS(p) + OFF_WT + (QUP ? WT_QUP : WT_KVUP));
  bf16_t* O = (bf16_t*)(WS(p) + OFF_E + (QUP ? 0 : SZ_QM));
  const int ldo = QUP ? 768 : 1024;
  const float* T32c = (const float*)(WS(p) + OFF_TAB) + 2 * 128 * 16;
  const float* T32s = T32c + 128 * 8;
  float* rr = (float*)(smem + 65536);
  const int brow = pm * 128, bcol = pn * 128;
  {
    const int lane = tid & 63, hw = lane >> 5, ch = lane & 31;
#pragma unroll 4
    for (int it = 0; it < 16; ++it) {
      const int r = (wid * 16 + it) * 2 + hw;
      const uint4 v = *(const uint4*)(A + (size_t)(brow + r) * NP + ch * 8);
      float a, ss = 0.f;
      a = bflo(v.x); ss += a * a; a = bfhi(v.x); ss += a * a;
      a = bflo(v.y); ss += a * a; a = bfhi(v.y); ss += a * a;
      a = bflo(v.z); ss += a * a; a = bfhi(v.z); ss += a * a;
      a = bflo(v.w); ss += a * a; a = bfhi(v.w); ss += a * a;
      ss = half_sum32(ss);
      if (ch == 0) rr[r] = rsqrtf(ss * (1.f / 256.f) + EPS);
    }
  }
  __syncthreads();
  f32x4 acc[4][4];
  zero_acc<4>(acc);
  gemm_run<4>(job_up<QUP>(p, pm, pn), smem, acc);
  if (has_next) gemm_prefetch0(next, smem);
  const int cs = bcol + wc * 64;
#pragma unroll
  for (int m = 0; m < 4; ++m) {
    const int rl = wr * 64 + m * 16 + fr, row = brow + rl;
    const float sc = QUP ? rr[rl] * (0.10206207261596575f * LOG2E) : rr[rl];
#pragma unroll
    for (int n = 0; n < 4; ++n) acc[m][n] = acc[m][n] * sc;
    if (QUP) {
      const int t = row % TB;
      if (t >= CTX) {
        const int pos = t - CTX, prow = pos >> 6, pcol = pos & 63;
        const int pp = (fq < 2) ? prow : pcol;
#pragma unroll
        for (int n = 0; n < 3; ++n) {
          if ((cs + n * 16) % 96 == 64) {
#pragma unroll
            for (int j = 0; j < 4; ++j) {
              const int f = (fq & 1) * 4 + j;
              const float cv = T32c[pp * 8 + f], sv = T32s[pp * 8 + f];
              const float x1 = acc[m][n][j], x2 = acc[m][n + 1][j];
              acc[m][n][j] = x1 * cv - x2 * sv;
              acc[m][n + 1][j] = x1 * sv + x2 * cv;
            }
          }
        }
      }
    }
  }
  store_tile_lds<4>(acc, O, ldo, brow, bcol, smem);
}

__device__ __forceinline__ GemmJob job_merge(const Params& p, int brow, int pn, int br, int nm) {
  GemmJob j;
  j.A = (br == 0) ? (const bf16_t*)(WS(p) + OFF_D) : (br == 1) ? (const bf16_t*)(WS(p) + OFF_D + SZ_YC) : (const bf16_t*)(WS(p) + OFF_YC);
  j.Bt = (const bf16_t*)(WS(p) + OFF_WT + WT_BR + (size_t)br * 1024 * 512 * 2);
  j.lda = 512; j.ldb = 512; j.K = 512; j.brow = brow; j.bcol = pn * 128; j.nm = nm; return j;
}
template <int NM>
__device__ __forceinline__ void tile_merge(const Params& p, int brow, int pn, char* smem, const GemmJob next, const bool has_next) {
  const int tid = tidx(), wid = tid >> 6, lane = tid & 63, wr = wid >> 1, wc = wid & 1, fr = lane & 15, fq = lane >> 4;
  const bf16_t* P = (const bf16_t*)(WS(p) + OFF_P);
  bf16_t* Y = (bf16_t*)(WS(p) + OFF_E);
  const int bcol = pn * 128, cs = bcol + wc * 64;
  f32x4 yacc[NM][4];
  zero_acc<NM>(yacc);
#pragma unroll 1
  for (int br = 0; br < 3; ++br) {
    f32x4 acc[NM][4];
    zero_acc<NM>(acc);
    gemm_run<NM>(job_merge(p, brow, pn, br, NM), smem, acc);
    uint2 gt[NM][4];
#pragma unroll
    for (int m = 0; m < NM; ++m) {
      const int row = brow + wr * 16 * NM + m * 16 + fr;
#pragma unroll
      for (int n = 0; n < 4; ++n) gt[m][n] = *(const uint2*)(P + (size_t)row * NP + C_GATE + br * 1024 + cs + n * 16 + fq * 4);
    }
    __builtin_amdgcn_sched_barrier(0);
    if (br < 2) gemm_prefetch0(job_merge(p, brow, pn, br + 1, NM), smem);
    else if (has_next) gemm_prefetch0(next, smem);
#pragma unroll
    for (int m = 0; m < NM; ++m) {
#pragma unroll
      for (int n = 0; n < 4; ++n) {
        const uint2 g = gt[m][n];
        yacc[m][n][0] += sigmoidf_(bflo(g.x)) * acc[m][n][0];
        yacc[m][n][1] += sigmoidf_(bfhi(g.x)) * acc[m][n][1];
        yacc[m][n][2] += sigmoidf_(bflo(g.y)) * acc[m][n][2];
        yacc[m][n][3] += sigmoidf_(bfhi(g.y)) * acc[m][n][3];
      }
    }
  }
  store_tile_lds<NM>(yacc, Y, 1024, brow, bcol, smem);
}

__device__ __forceinline__ GemmJob job_plain(const bf16_t* A, int lda, const bf16_t* Wt, int K, int brow, int pn, int nm) {
  GemmJob j; j.A = A; j.Bt = Wt; j.lda = lda; j.ldb = K; j.K = K; j.brow = brow; j.bcol = pn * 128; j.nm = nm; return j;
}
template <int ACT, int NM>
__device__ __forceinline__ void tile_plain(const bf16_t* A, int lda, const bf16_t* Wt, int K, bf16_t* O, int ldo, int brow, int pn, char* smem,
                                           const GemmJob next, const bool has_next) {
  const int tid = tidx(), wid = tid >> 6, lane = tid & 63, wr = wid >> 1, wc = wid & 1, fr = lane & 15, fq = lane >> 4;
  const int bcol = pn * 128, cs = bcol + wc * 64;
  f32x4 acc[NM][4];
  zero_acc<NM>(acc);
  gemm_run<NM>(job_plain(A, lda, Wt, K, brow, pn, NM), smem, acc);
  if (has_next) gemm_prefetch0(next, smem);
  if (ACT == 1) {
#pragma unroll
    for (int m = 0; m < NM; ++m)
#pragma unroll
      for (int n = 0; n < 4; ++n)
#pragma unroll
        for (int j = 0; j < 4; ++j) { const float r = fmaxf(acc[m][n][j], 0.f); acc[m][n][j] = r * r; }
  }
  store_tile_lds<NM>(acc, O, ldo, brow, bcol, smem);
}

template <int NCH>
__device__ __forceinline__ void load_tile64(const bf16_t* g, size_t ld, bf16_t* s, int LP, int tid) {
#pragma unroll
  for (int c0 = 0; c0 < 64 * NCH; c0 += 256) {
    const int c = c0 + tid, r = c / NCH, ch = c % NCH;
    const uint4 v = *(const uint4*)(g + (size_t)r * ld + ch * 8);
    *(uint4*)(s + r * LP + ch * 8) = v;
  }
}

template <int DQK, bool NA>
__device__ __forceinline__ void attn_tile(const bf16_t* Q, int ldq, const bf16_t* K1, int ldk1, const bf16_t* K2, int ldk2,
                                          const bf16_t* V, int ldv, bf16_t* O, int ldo, int nlin, int nloc, int loc_row0,
                                          float sl2, const float* rpb_h, int r_base, char* smem) {
  constexpr int NKS = DQK / 32, KBYTES = NKS * 4096, STG = KBYTES + 8192;
  const int tid = tidx(), wid = tid >> 6, lane = tid & 63, fr = lane & 15, fq = lane >> 4;
  float* rpb_s = (float*)(smem + 2 * STG);
  __syncthreads();
  if (NA) {
    for (int i = tid; i < 15 * 31; i += 256) rpb_s[i] = rpb_h[i] * LOG2E;
  }
  const int sr = tid >> 3, sch = tid & 7;
  const int sw_s = (0x78 >> (2 * ((sr >> 2) & 3))) & 3;
  const int k1_off = (sch >> 2) * 4096 + sr * 64 + (((sch & 3) ^ sw_s) << 4);
  const int v_off = KBYTES + sr * 128 + ((((sch >> 1) ^ ((sr >> 1) & 3))) << 5) + ((sch & 1) << 4);
  const int s2r = tid >> 2, s2p = tid & 3;
  const int sw_s2 = (0x78 >> (2 * ((s2r >> 2) & 3))) & 3;
  const int k2_off = 2 * 4096 + s2r * 64 + ((s2p ^ sw_s2) << 4);
  const bf16_t* gk1 = K1 + (size_t)sr * ldk1 + sch * 8;
  const bf16_t* gv = V + (size_t)sr * ldv + sch * 8;
  const bf16_t* gk2 = (DQK == 96) ? K2 + (size_t)s2r * ldk2 + s2p * 8 : nullptr;
  const int sw_r = (0x78 >> (2 * (fr >> 2))) & 3;
  const int koff = fr * 64 + ((fq ^ sw_r) << 4);
  const int xr = (2 * fq + (fr >> 3)) & 3;
  int voff[4];
#pragma unroll
  for (int db = 0; db < 4; ++db) voff[db] = KBYTES + (4 * fq + (fr >> 2)) * 128 + ((db ^ xr) << 5) + (fr & 3) * 8;

  bf16x8 qf[2][NKS];
#pragma unroll
  for (int q = 0; q < 2; ++q)
#pragma unroll
    for (int ks = 0; ks < NKS; ++ks) qf[q][ks] = *(const bf16x8*)(Q + (size_t)(wid * 32 + q * 16 + fr) * ldq + ks * 32 + fq * 8);
  f32x4 Oa[4][2];
#pragma unroll
  for (int db = 0; db < 4; ++db) { Oa[db][0] = (f32x4){0.f, 0.f, 0.f, 0.f}; Oa[db][1] = (f32x4){0.f, 0.f, 0.f, 0.f}; }
  float mrun[2] = {0.f, 0.f};
  f32x4 negm[2] = {(f32x4){0.f, 0.f, 0.f, 0.f}, (f32x4){0.f, 0.f, 0.f, 0.f}};
  f32x4 Osum[2] = {(f32x4){0.f, 0.f, 0.f, 0.f}, (f32x4){0.f, 0.f, 0.f, 0.f}};
  const bf16x8 ones = {16256, 16256, 16256, 16256, 16256, 16256, 16256, 16256};
  int qrow[2], qcol[2], r0q[2], c0q[2];
  if (NA) {
#pragma unroll
    for (int q = 0; q < 2; ++q) {
      const int qi = wid * 32 + q * 16 + fr;
      qrow[q] = r_base + (qi >> 6); qcol[q] = qi & 63;
      r0q[q] = min(max(qrow[q] - 4, 0), 120);
      c0q[q] = min(max(qcol[q] - 8, 0), 48);
    }
  }
  const int ntile = nlin + nloc;
  uint4 k1aRA, k1bRA, k2RA, vaRA, vbRA, k1aRB, k1bRB, k2RB, vaRB, vbRB;
#define ATT_LOAD(R, T)                                                                                \
  do {                                                                                                \
    const int t_ = (T);                                                                               \
    const size_t krow_ = (t_ < nlin) ? (size_t)t_ * 64 : (size_t)(CTX + (loc_row0 + (t_ - nlin)) * 64); \
    k1a##R = *(const uint4*)(gk1 + krow_ * ldk1);                                                      \
    k1b##R = *(const uint4*)(gk1 + (krow_ + 32) * ldk1);                                               \
    if (DQK == 96) k2##R = *(const uint4*)(gk2 + krow_ * ldk2);                                        \
    va##R = *(const uint4*)(gv + krow_ * ldv);                                                         \
    vb##R = *(const uint4*)(gv + (krow_ + 32) * ldv);                                                  \
  } while (0)
#define ATT_STORE(R, BUF)                                                                             \
  do {                                                                                                \
    char* st_ = smem + (BUF) * STG;                                                                   \
    *(uint4*)(st_ + k1_off) = k1a##R;                                                                  \
    *(uint4*)(st_ + k1_off + 2048) = k1b##R;                                                           \
    if (DQK == 96) *(uint4*)(st_ + k2_off) = k2##R;                                                    \
    *(uint4*)(st_ + v_off) = va##R;                                                                    \
    *(uint4*)(st_ + v_off + 4096) = vb##R;                                                             \
  } while (0)
  ATT_LOAD(RA, 0);
  ATT_STORE(RA, 0);
  if (ntile > 1) ATT_LOAD(RB, 1);
  __syncthreads();
#pragma unroll 1
  for (int t0 = 0; t0 < ntile; t0 += 2) {
#pragma unroll
  for (int par = 0; par < 2; ++par) {
    const int t = t0 + par;
    if (t < ntile) {
    const char* stg = smem + par * STG;
    if (t + 2 < ntile) { if (par == 0) ATT_LOAD(RA, t + 2); else ATT_LOAD(RB, t + 2); }
    f32x4 S[4][2];
    {
      bf16x8 kf[4][NKS];
#pragma unroll
      for (int kb = 0; kb < 4; ++kb)
#pragma unroll
        for (int ks = 0; ks < NKS; ++ks) kf[kb][ks] = *(const bf16x8*)(stg + ks * 4096 + kb * 1024 + koff);
      __builtin_amdgcn_sched_barrier(0);
#pragma unroll
      for (int kb = 0; kb < 4; ++kb) {
        S[kb][0] = negm[0]; S[kb][1] = negm[1];
#pragma unroll
        for (int ks = 0; ks < NKS; ++ks) {
          S[kb][0] = mfma16(kf[kb][ks], qf[0][ks], S[kb][0]);
          S[kb][1] = mfma16(kf[kb][ks], qf[1][ks], S[kb][1]);
        }
      }
      __builtin_amdgcn_sched_barrier(0);
    }
    const bool local = NA && (t >= nlin);
    const int kr = loc_row0 + (t - nlin);
    float mxq[2];
#pragma unroll
    for (int q = 0; q < 2; ++q) {
      if (NA) {
        if (local) {
          const bool rok = (kr >= r0q[q]) && (kr < r0q[q] + 8);
          const int u0 = fq * 4 - c0q[q];
          const float* bp = rpb_s + (kr - qrow[q] + 7) * 31 + (fq * 4 - qcol[q] + 15);
#pragma unroll
          for (int kb = 0; kb < 4; ++kb)
#pragma unroll
            for (int j = 0; j < 4; ++j) {
              const bool ok = rok && ((unsigned)(u0 + kb * 16 + j) < 16u);
              const float sb = S[kb][q][j] + bp[kb * 16 + j];
              S[kb][q][j] = ok ? sb : -1e30f;
            }
        }
      }
      float mx = fmax_nc(fmax_nc(S[0][q][0], S[0][q][1]), fmax_nc(S[0][q][2], S[0][q][3]));
#pragma unroll
      for (int kb = 1; kb < 4; ++kb) mx = fmax_nc(fmax_nc(mx, fmax_nc(S[kb][q][0], S[kb][q][1])), fmax_nc(S[kb][q][2], S[kb][q][3]));
      mx = xmax16(mx);
      mx = xmax32(mx);
      mxq[q] = mx;
    }
    const bool first = (t == 0);
    if (first || __any((mxq[0] > 8.f) || (mxq[1] > 8.f))) {
#pragma unroll
      for (int q = 0; q < 2; ++q) {
        const float d = (first || mxq[q] > 8.f) ? mxq[q] : 0.f;
        const float alpha = __builtin_amdgcn_exp2f(-d);
        mrun[q] += d;
        negm[q] = (f32x4){-mrun[q], -mrun[q], -mrun[q], -mrun[q]};
        Osum[q] = Osum[q] * alpha;
#pragma unroll
        for (int db = 0; db < 4; ++db) Oa[db][q] = Oa[db][q] * alpha;
#pragma unroll
        for (int kb = 0; kb < 4; ++kb) S[kb][q] = S[kb][q] - d;
      }
    }
#pragma unroll
    for (int q = 0; q < 2; ++q)
#pragma unroll
      for (int kb = 0; kb < 4; ++kb)
#pragma unroll
        for (int j = 0; j < 4; ++j) S[kb][q][j] = __builtin_amdgcn_exp2f(S[kb][q][j]);
#pragma unroll
    for (int ks2 = 0; ks2 < 2; ++ks2) {
      bf16x8 pf[2];
#pragma unroll
      for (int q = 0; q < 2; ++q) {
        union { bf16x8 v; unsigned u[4]; } cv;
        cv.u[0] = pack2(S[2 * ks2][q][0], S[2 * ks2][q][1]);
        cv.u[1] = pack2(S[2 * ks2][q][2], S[2 * ks2][q][3]);
        cv.u[2] = pack2(S[2 * ks2 + 1][q][0], S[2 * ks2 + 1][q][1]);
        cv.u[3] = pack2(S[2 * ks2 + 1][q][2], S[2 * ks2 + 1][q][3]);
        pf[q] = cv.v;
      }
      bf16x8 vf[4];
#pragma unroll
      for (int db = 0; db < 4; ++db) {
        const s16x4 v1 = tr_read((const bf16_t*)(stg + (2 * ks2) * 2048 + voff[db]));
        const s16x4 v2 = tr_read((const bf16_t*)(stg + (2 * ks2 + 1) * 2048 + voff[db]));
        vf[db] = (bf16x8){v1[0], v1[1], v1[2], v1[3], v2[0], v2[1], v2[2], v2[3]};
      }
      __builtin_amdgcn_sched_barrier(0);
      Osum[0] = mfma16(ones, pf[0], Osum[0]);
      Osum[1] = mfma16(ones, pf[1], Osum[1]);
#pragma unroll
      for (int db = 0; db < 4; ++db) {
        Oa[db][0] = mfma16(vf[db], pf[0], Oa[db][0]);
        Oa[db][1] = mfma16(vf[db], pf[1], Oa[db][1]);
      }
      __builtin_amdgcn_sched_barrier(0);
    }
    if (t + 1 < ntile) { if (par == 0) ATT_STORE(RB, 1); else ATT_STORE(RA, 0); }
    __syncthreads();
    }
  }
  }
#undef ATT_LOAD
#undef ATT_STORE
#pragma unroll
  for (int q = 0; q < 2; ++q) {
    const float inv = 1.f / Osum[q][0];
    bf16_t* orow = O + (size_t)(wid * 32 + q * 16 + fr) * ldo;
#pragma unroll
    for (int db = 0; db < 4; ++db) store4(orow + db * 16 + fq * 4, Oa[db][q] * inv);
  }
}

__device__ __forceinline__ void tile_mla(const Params& p, int idx, char* smem) {
  const int qt = idx % 66, bh = idx / 66, h = bh & 7, b = bh >> 3;
  const bf16_t* Qm = (const bf16_t*)(WS(p) + OFF_E);
  const bf16_t* KVm = (const bf16_t*)(WS(p) + OFF_E + SZ_QM);
  const bf16_t* P = (const bf16_t*)(WS(p) + OFF_P);
  bf16_t* yc = (bf16_t*)(WS(p) + OFF_YC);
  const bool isx = qt < 64;
  const int qrow0 = b * TB + (isx ? CTX + qt * 128 : (qt - 64) * 128);
  const size_t brow = (size_t)b * TB;
  attn_tile<96, false>(Qm + (size_t)qrow0 * 768 + h * 96, 768, KVm + brow * 1024 + h * 128, 1024, P + brow * NP + C_KR, NP,
                       KVm + brow * 1024 + h * 128 + 64, 1024, yc + (size_t)qrow0 * 512 + h * 64, 512, isx ? TB / 64 : CTX / 64, 0, 0,
                       0.10206207261596575f * LOG2E, nullptr, 0, smem);
}
__device__ __forceinline__ void tile_na(const Params& p, int l, int idx, char* smem) {
  const int qt = idx % 66, bh = idx / 66, h = bh & 7, b = bh >> 3;
  const bf16_t* P = (const bf16_t*)(WS(p) + OFF_P);
  bf16_t* yb = (bf16_t*)(WS(p) + OFF_D + SZ_YC);
  const bool isx = qt < 64;
  const int qrow0 = b * TB + (isx ? CTX + qt * 128 : (qt - 64) * 128);
  const size_t brow = (size_t)b * TB;
  int nloc = 0, rlo = 0;
  if (isx) {
    const int r = 2 * qt;
    rlo = min(max(r - 4, 0), 120);
    const int rhi = min(max(r + 1 - 4, 0), 120) + 7;
    nloc = rhi - rlo + 1;
  }
  attn_tile<64, true>(P + (size_t)qrow0 * NP + C_NQ + h * 64, NP, P + brow * NP + C_NK + h * 64, NP, nullptr, 0,
                      P + brow * NP + C_NV + h * 64, NP, yb + (size_t)qrow0 * 512 + h * 64, 512, CTX / 64, nloc, rlo, 0.125f * LOG2E,
                      p.na_rpb + ((size_t)l * 8 + h) * 15 * 31, 2 * qt, smem);
}

__device__ __forceinline__ float ret_lg2(const Params& p, int l, int dir, int h) {
  const float ld = p.ret_log_decay[(l * 2 + dir) * 4 + h];
  return log1pf(-expf(ld)) * LOG2E;
}
__device__ __forceinline__ void tile_retkv(const Params& p, int l, int idx, char* smem) {
  const int tid = tidx(), wid = tid >> 6, lane = tid & 63, fr = lane & 15, fq = lane >> 4;
  const int c = idx % NCHUNK, bh = idx / NCHUNK, h = bh & 3, b = bh >> 2;
  const bf16_t* P = (const bf16_t*)(WS(p) + OFF_P);
  float* ST = (float*)(WS(p) + OFF_ST);
  const size_t row0 = (size_t)b * TB + c * 128;
  const float lgf = ret_lg2(p, l, 0, h), lgb = ret_lg2(p, l, 1, h);
  constexpr int KP = 72, VP = 136;
  bf16_t* Kf = (bf16_t*)smem;
  bf16_t* Kb = Kf + 64 * KP;
  bf16_t* Vs = Kb + 64 * KP;
  f32x4 acc[2][4][2];
#pragma unroll
  for (int d = 0; d < 2; ++d)
#pragma unroll
    for (int a = 0; a < 4; ++a) { acc[d][a][0] = (f32x4){0.f, 0.f, 0.f, 0.f}; acc[d][a][1] = (f32x4){0.f, 0.f, 0.f, 0.f}; }
#pragma unroll 1
  for (int sh = 0; sh < 2; ++sh) {
    __syncthreads();
#pragma unroll
    for (int c0 = 0; c0 < 512; c0 += 256) {
      const int cc = c0 + tid, r = cc >> 3, ch = cc & 7;
      const int s = sh * 64 + r;
      const uint4 v = *(const uint4*)(P + (row0 + s) * NP + C_RK + h * 64 + ch * 8);
      const float df = __builtin_amdgcn_exp2f(lgf * (float)(127 - s)), db = __builtin_amdgcn_exp2f(lgb * (float)s);
      uint4 wf, wb;
      wf.x = pack2(bflo(v.x) * df, bfhi(v.x) * df); wb.x = pack2(bflo(v.x) * db, bfhi(v.x) * db);
      wf.y = pack2(bflo(v.y) * df, bfhi(v.y) * df); wb.y = pack2(bflo(v.y) * db, bfhi(v.y) * db);
      wf.z = pack2(bflo(v.z) * df, bfhi(v.z) * df); wb.z = pack2(bflo(v.z) * db, bfhi(v.z) * db);
      wf.w = pack2(bflo(v.w) * df, bfhi(v.w) * df); wb.w = pack2(bflo(v.w) * db, bfhi(v.w) * db);
      *(uint4*)(Kf + r * KP + ch * 8) = wf;
      *(uint4*)(Kb + r * KP + ch * 8) = wb;
    }
    load_tile64<16>(P + (row0 + sh * 64) * NP + C_RV + h * 128, NP, Vs, VP, tid);
    __syncthreads();
#pragma unroll
    for (int ks = 0; ks < 2; ++ks) {
      const int ra = (ks * 32 + 4 * fq + (fr >> 2)), rb = ra + 16, co = 4 * (fr & 3);
      bf16x8 vf[2];
#pragma unroll
      for (int dvb = 0; dvb < 2; ++dvb) {
        const s16x4 v1 = tr_read(Vs + ra * VP + (wid * 2 + dvb) * 16 + co);
        const s16x4 v2 = tr_read(Vs + rb * VP + (wid * 2 + dvb) * 16 + co);
        vf[dvb] = (bf16x8){v1[0], v1[1], v1[2], v1[3], v2[0], v2[1], v2[2], v2[3]};
      }
#pragma unroll
      for (int dkb = 0; dkb < 4; ++dkb) {
        const s16x4 a1 = tr_read(Kf + ra * KP + dkb * 16 + co);
        const s16x4 a2 = tr_read(Kf + rb * KP + dkb * 16 + co);
        const bf16x8 kff = {a1[0], a1[1], a1[2], a1[3], a2[0], a2[1], a2[2], a2[3]};
        const s16x4 b1 = tr_read(Kb + ra * KP + dkb * 16 + co);
        const s16x4 b2 = tr_read(Kb + rb * KP + dkb * 16 + co);
        const bf16x8 kfb = {b1[0], b1[1], b1[2], b1[3], b2[0], b2[1], b2[2], b2[3]};
#pragma unroll
        for (int dvb = 0; dvb < 2; ++dvb) {
          acc[0][dkb][dvb] = mfma16(kff, vf[dvb], acc[0][dkb][dvb]);
          acc[1][dkb][dvb] = mfma16(kfb, vf[dvb], acc[1][dkb][dvb]);
        }
      }
    }
  }
#pragma unroll
  for (int d = 0; d < 2; ++d) {
    float* dst = ST + ((size_t)((d * 2 + b) * 4 + h) * NCHUNK + c) * 8192;
#pragma unroll
    for (int dkb = 0; dkb < 4; ++dkb)
#pragma unroll
      for (int dvb = 0; dvb < 2; ++dvb)
#pragma unroll
        for (int j = 0; j < 4; ++j) dst[(dkb * 16 + 4 * fq + j) * 128 + (wid * 2 + dvb) * 16 + fr] = acc[d][dkb][dvb][j];
  }
}
__device__ __forceinline__ void unit_scan(const Params& p, int l, int u) {
  const int e = u * 256 + tidx();
  const int i = e & 8191, h = (e >> 13) & 3, b = (e >> 15) & 1, dir = e >> 16;
  float* base = (float*)(WS(p) + OFF_ST) + (size_t)((dir * 2 + b) * 4 + h) * NCHUNK * 8192 + i;
  const float cd = exp2f(ret_lg2(p, l, dir, h) * 128.f);
  float s = 0.f;
#pragma unroll 1
  for (int k0 = 0; k0 < NCHUNK; k0 += 33) {
    float tmp[33];
#pragma unroll
    for (int k = 0; k < 33; ++k) {
      const int kk = k0 + k;
      const int c = dir == 0 ? kk : (kk < 2 ? 1 - kk : NCHUNK + 1 - kk);
      tmp[k] = base[(size_t)c * 8192];
    }
#pragma unroll
    for (int k = 0; k < 33; ++k) {
      const int kk = k0 + k;
      const int c = dir == 0 ? kk : (kk < 2 ? 1 - kk : NCHUNK + 1 - kk);
      base[(size_t)c * 8192] = s;
      s = s * cd + tmp[k];
    }
  }
}
__device__ __forceinline__ void tile_retout(const Params& p, int l, int idx, char* smem) {
  const int tid = tidx(), wid = tid >> 6, lane = tid & 63, fr = lane & 15, fq = lane >> 4;
  const int qh = idx & 1, cidx = idx >> 1, c = cidx % NCHUNK, bh = cidx / NCHUNK, h = bh & 3, b = bh >> 2;
  const bf16_t* P = (const bf16_t*)(WS(p) + OFF_P);
  const float* ST = (const float*)(WS(p) + OFF_ST);
  bf16_t* ya = (bf16_t*)(WS(p) + OFF_D);
  const size_t row0 = (size_t)b * TB + c * 128;
  constexpr int KP = 72, VP = 136;
  bf16_t* Ks = (bf16_t*)smem;
  bf16_t* Vs = Ks + 64 * KP;
  bf16_t* Ss = Vs + 64 * VP;
  const int n = qh * 64 + wid * 16 + fr;
  const size_t qrow = row0 + n;
  const bf16_t* qp = P + qrow * NP + C_RQ + h * 64;
  bf16x8 qf[2];
  qf[0] = *(const bf16x8*)(qp + fq * 8);
  qf[1] = *(const bf16x8*)(qp + 32 + fq * 8);
  float qx[2][8];
#pragma unroll
  for (int ks = 0; ks < 2; ++ks) {
    const uint2 a = *(const uint2*)(qp + ks * 32 + 4 * fq);
    const uint2 bq = *(const uint2*)(qp + ks * 32 + 16 + 4 * fq);
    qx[ks][0] = bflo(a.x); qx[ks][1] = bfhi(a.x); qx[ks][2] = bflo(a.y); qx[ks][3] = bfhi(a.y);
    qx[ks][4] = bflo(bq.x); qx[ks][5] = bfhi(bq.x); qx[ks][6] = bflo(bq.y); qx[ks][7] = bfhi(bq.y);
  }
  bf16_t* yp = ya + qrow * 512 + h * 128;
  const float lg01[2] = {ret_lg2(p, l, 0, h), ret_lg2(p, l, 1, h)};
  uint4 pre[8];
  f32x4 Oa[8];
#define RO_ISX(i) (qh == 0 ? ((i) == 1 || (i) == 4) : ((i) == 2 || (i) == 4))
#define RO_DIR(i) (qh == 0 ? ((i) >= 2 ? 1 : 0) : ((i) >= 3 ? 1 : 0))
#define RO_KH(i) (qh == 0 ? ((i) == 3 ? 1 : 0) : ((i) == 0 ? 0 : 1))
#define RO_ISSUE(i)                                                                                                 \
  do {                                                                                                              \
    const int i_ = (i);                                                                                             \
    if (RO_ISX(i_)) {                                                                                               \
      const float* sp_ = ST + ((size_t)((RO_DIR(i_) * 2 + b) * 4 + h) * NCHUNK + c) * 8192;                         \
      _Pragma("unroll") for (int j_ = 0; j_ < 8; ++j_) pre[j_] = *(const uint4*)(sp_ + (j_ * 256 + tid) * 4);       \
    } else {                                                                                                        \
      const size_t kr_ = row0 + RO_KH(i_) * 64;                                                                     \
      _Pragma("unroll") for (int j_ = 0; j_ < 2; ++j_) {                                                            \
        const int cc_ = j_ * 256 + tid;                                                                             \
        pre[j_] = *(const uint4*)(P + (kr_ + (cc_ >> 3)) * NP + C_RK + h * 64 + (cc_ & 7) * 8);                     \
      }                                                                                                             \
      _Pragma("unroll") for (int j_ = 0; j_ < 4; ++j_) {                                                            \
        const int cc_ = j_ * 256 + tid;                                                                             \
        pre[2 + j_] = *(const uint4*)(P + (kr_ + (cc_ >> 4)) * NP + C_RV + h * 128 + (cc_ & 15) * 8);               \
      }                                                                                                             \
    }                                                                                                               \
  } while (0)
  RO_ISSUE(0);
#pragma unroll 1
  for (int i = 0; i < 5; ++i) {
    const bool isx = RO_ISX(i);
    const int dir = RO_DIR(i), kh = RO_KH(i);
    const float lg = lg01[dir];
    __syncthreads();
    if (isx) {
#pragma unroll
      for (int j = 0; j < 8; ++j) {
        const int cc = j * 256 + tid, r = cc >> 5, ch = cc & 31;
        uint2 w;
        w.x = pack2(__uint_as_float(pre[j].x), __uint_as_float(pre[j].y));
        w.y = pack2(__uint_as_float(pre[j].z), __uint_as_float(pre[j].w));
        *(uint2*)(Ss + r * VP + ch * 4) = w;
      }
    } else {
#pragma unroll
      for (int j = 0; j < 2; ++j) { const int cc = j * 256 + tid; *(uint4*)(Ks + (cc >> 3) * KP + (cc & 7) * 8) = pre[j]; }
#pragma unroll
      for (int j = 0; j < 4; ++j) { const int cc = j * 256 + tid; *(uint4*)(Vs + (cc >> 4) * VP + (cc & 15) * 8) = pre[2 + j]; }
    }
    if (i + 1 < 5) RO_ISSUE(i + 1);
    __syncthreads();
    if (i == 0 || i == (qh == 0 ? 2 : 3)) {
#pragma unroll
      for (int db = 0; db < 8; ++db) Oa[db] = (f32x4){0.f, 0.f, 0.f, 0.f};
    }
    if (!isx) {
      f32x4 S[4];
#pragma unroll
      for (int kb = 0; kb < 4; ++kb) {
        S[kb] = (f32x4){0.f, 0.f, 0.f, 0.f};
#pragma unroll
        for (int ks = 0; ks < 2; ++ks) {
          const bf16x8 kf = *(const bf16x8*)(Ks + (kb * 16 + fr) * KP + ks * 32 + fq * 8);
          S[kb] = mfma16(kf, qf[ks], S[kb]);
        }
#pragma unroll
        for (int j = 0; j < 4; ++j) {
          const int m = kh * 64 + kb * 16 + 4 * fq + j;
          const int dd = dir == 0 ? (n - m) : (m - n);
          const float w = dd >= 0 ? __builtin_amdgcn_exp2f(lg * (float)dd) : 0.f;
          S[kb][j] *= w;
        }
      }
#pragma unroll
      for (int ks2 = 0; ks2 < 2; ++ks2) {
        union { bf16x8 v; unsigned u[4]; } cv;
        cv.u[0] = pack2(S[2 * ks2][0], S[2 * ks2][1]);
        cv.u[1] = pack2(S[2 * ks2][2], S[2 * ks2][3]);
        cv.u[2] = pack2(S[2 * ks2 + 1][0], S[2 * ks2 + 1][1]);
        cv.u[3] = pack2(S[2 * ks2 + 1][2], S[2 * ks2 + 1][3]);
#pragma unroll
        for (int db = 0; db < 8; ++db) {
          const s16x4 v1 = tr_read(Vs + ((2 * ks2) * 16 + 4 * fq + (fr >> 2)) * VP + db * 16 + 4 * (fr & 3));
          const s16x4 v2 = tr_read(Vs + ((2 * ks2 + 1) * 16 + 4 * fq + (fr >> 2)) * VP + db * 16 + 4 * (fr & 3));
          const bf16x8 vf = {v1[0], v1[1], v1[2], v1[3], v2[0], v2[1], v2[2], v2[3]};
          Oa[db] = mfma16(vf, cv.v, Oa[db]);
        }
      }
    } else {
      const float qd = __builtin_amdgcn_exp2f(lg * (float)(dir == 0 ? (n + 1) : (128 - n)));
#pragma unroll
      for (int ks = 0; ks < 2; ++ks) {
        union { bf16x8 v; unsigned u[4]; } cv;
        cv.u[0] = pack2(qx[ks][0] * qd, qx[ks][1] * qd);
        cv.u[1] = pack2(qx[ks][2] * qd, qx[ks][3] * qd);
        cv.u[2] = pack2(qx[ks][4] * qd, qx[ks][5] * qd);
        cv.u[3] = pack2(qx[ks][6] * qd, qx[ks][7] * qd);
#pragma unroll
        for (int db = 0; db < 8; ++db) {
          const s16x4 v1 = tr_read(Ss + (ks * 32 + 4 * fq + (fr >> 2)) * VP + db * 16 + 4 * (fr & 3));
          const s16x4 v2 = tr_read(Ss + (ks * 32 + 16 + 4 * fq + (fr >> 2)) * VP + db * 16 + 4 * (fr & 3));
          const bf16x8 sf = {v1[0], v1[1], v1[2], v1[3], v2[0], v2[1], v2[2], v2[3]};
          Oa[db] = mfma16(sf, cv.v, Oa[db]);
        }
      }
      float sm = 0.f;
#pragma unroll
      for (int db = 0; db < 8; ++db) sm += (Oa[db][0] + Oa[db][1]) + (Oa[db][2] + Oa[db][3]);
      sm = xadd32(xadd16(sm));
      const float mean = sm * (1.f / 128.f);
      float vq = 0.f;
#pragma unroll
      for (int db = 0; db < 8; ++db)
#pragma unroll
        for (int j = 0; j < 4; ++j) { const float dlt = Oa[db][j] - mean; vq += dlt * dlt; }
      vq = xadd32(xadd16(vq));
      const float rstd = rsqrtf(vq * (1.f / 128.f) + EPS);
      const bf16_t* gp = P + qrow * NP + (dir == 0 ? C_GF : C_GB) + h * 128;
      const float* gn = p.ret_gn_gain + l * 512 + h * 128;
#pragma unroll
      for (int db = 0; db < 8; ++db) {
        const uint2 g = *(const uint2*)(gp + db * 16 + 4 * fq);
        const float4 gg = *(const float4*)(gn + db * 16 + 4 * fq);
        const float g0 = bflo(g.x), g1 = bfhi(g.x), g2 = bflo(g.y), g3 = bfhi(g.y);
        f32x4 y;
        y[0] = g0 * sigmoidf_(g0) * ((Oa[db][0] - mean) * rstd * gg.x);
        y[1] = g1 * sigmoidf_(g1) * ((Oa[db][1] - mean) * rstd * gg.y);
        y[2] = g2 * sigmoidf_(g2) * ((Oa[db][2] - mean) * rstd * gg.z);
        y[3] = g3 * sigmoidf_(g3) * ((Oa[db][3] - mean) * rstd * gg.w);
        if (dir == 1) {
          const uint2 pv = *(const uint2*)(yp + db * 16 + 4 * fq);
          y[0] += bflo(pv.x); y[1] += bfhi(pv.x); y[2] += bflo(pv.y); y[3] += bfhi(pv.y);
        }
        store4(yp + db * 16 + 4 * fq, y);
      }
    }
  }
#undef RO_ISX
#undef RO_DIR
#undef RO_KH
#undef RO_ISSUE
}

__device__ __forceinline__ void rows_phase(const Params& p, bool from_input, const bf16_t* add, int g_l, int g_chunk, const float* ln_g,
                                           const float* ln_b, int h_l, int sh_chunk, bf16_t* H) {
  const int wid = tidx() >> 6, lane = tidx() & 63;
  const float* MOD = (const float*)(WS(p) + OFF_MOD);
  const int stride = gridDim.x * 8;
  float4 xv[2][4];
  uint2 av[2][4];
#define ROWS_FETCH(R0)                                                                                                    \
  do {                                                                                                                    \
    _Pragma("unroll") for (int r_ = 0; r_ < 2; ++r_) {                                                                    \
      const int row_ = (R0) + r_;                                                                                         \
      const int b_ = row_ / TB, t_ = row_ - b_ * TB;                                                                      \
      const float* src_ = from_input ? (t_ < CTX ? p.ctx + (size_t)(b_ * CTX + t_) * D : p.x + ((size_t)b_ * SEQ + (t_ - CTX)) * D) \
                                     : xrow_ptr(p, row_);                                                                 \
      _Pragma("unroll") for (int i_ = 0; i_ < 4; ++i_) {                                                                  \
        xv[r_][i_] = *(const float4*)(src_ + i_ * 256 + lane * 4);                                                        \
        if (!from_input) av[r_][i_] = *(const uint2*)(add + (size_t)row_ * 1024 + i_ * 256 + lane * 4);                   \
      }                                                                                                                   \
    }                                                                                                                     \
  } while (0)
  float4 lng[4], lnb[4];
  if (!from_input) {
#pragma unroll
    for (int i = 0; i < 4; ++i) { lng[i] = *(const float4*)(ln_g + i * 256 + lane * 4); lnb[i] = *(const float4*)(ln_b + i * 256 + lane * 4); }
  }
  int row0 = (blockIdx.x * 4 + wid) * 2;
  if (row0 < MROWS) ROWS_FETCH(row0);
  for (; row0 < MROWS; row0 += stride) {
    float4 v[2][4];
    int mv[2];
    float* xr[2];
#pragma unroll
    for (int r = 0; r < 2; ++r) {
      const int row = row0 + r;
      const int b = row / TB, t = row - b * TB;
      mv[r] = t < CTX ? 2 : b;
      xr[r] = xrow_ptr(p, row);
      if (from_input) {
#pragma unroll
        for (int i = 0; i < 4; ++i) v[r][i] = xv[r][i];
      } else {
        const float* gm = MOD + (size_t)(g_l * 3 + mv[r]) * 6144 + g_chunk * 1024;
#pragma unroll
        for (int i = 0; i < 4; ++i) {
          const float4 gv = *(const float4*)(gm + i * 256 + lane * 4);
          v[r][i].x = ALPHA * xv[r][i].x + gv.x * bflo(av[r][i].x);
          v[r][i].y = ALPHA * xv[r][i].y + gv.y * bfhi(av[r][i].x);
          v[r][i].z = ALPHA * xv[r][i].z + gv.z * bflo(av[r][i].y);
          v[r][i].w = ALPHA * xv[r][i].w + gv.w * bfhi(av[r][i].y);
        }
      }
    }
    float4 shv[4], scv[4];
    if (H) {
      const float* mm = MOD + (size_t)(h_l * 3 + mv[0]) * 6144;
#pragma unroll
      for (int i = 0; i < 4; ++i) {
        shv[i] = *(const float4*)(mm + sh_chunk * 1024 + i * 256 + lane * 4);
        scv[i] = *(const float4*)(mm + (sh_chunk + 1) * 1024 + i * 256 + lane * 4);
      }
    }
    if (row0 + stride < MROWS) ROWS_FETCH(row0 + stride);
    if (!from_input) {
      float s[2], q[2];
#pragma unroll
      for (int r = 0; r < 2; ++r) {
        s[r] = 0.f;
#pragma unroll
        for (int i = 0; i < 4; ++i) s[r] += (v[r][i].x + v[r][i].y) + (v[r][i].z + v[r][i].w);
      }
      s[0] = wave_sum(s[0]); s[1] = wave_sum(s[1]);
#pragma unroll
      for (int r = 0; r < 2; ++r) {
        const float mean = s[r] * (1.f / 1024.f);
        s[r] = mean;
        q[r] = 0.f;
#pragma unroll
        for (int i = 0; i < 4; ++i) {
          const float a0 = v[r][i].x - mean, a1 = v[r][i].y - mean, a2 = v[r][i].z - mean, a3 = v[r][i].w - mean;
          q[r] += (a0 * a0 + a1 * a1) + (a2 * a2 + a3 * a3);
        }
      }
      q[0] = wave_sum(q[0]); q[1] = wave_sum(q[1]);
#pragma unroll
      for (int i = 0; i < 4; ++i) {
        const float4 gg = lng[i], bb = lnb[i];
#pragma unroll
        for (int r = 0; r < 2; ++r) {
          const float mean = s[r], rstd = rsqrtf(q[r] * (1.f / 1024.f) + EPS);
          v[r][i].x = (v[r][i].x - mean) * rstd * gg.x + bb.x;
          v[r][i].y = (v[r][i].y - mean) * rstd * gg.y + bb.y;
          v[r][i].z = (v[r][i].z - mean) * rstd * gg.z + bb.z;
          v[r][i].w = (v[r][i].w - mean) * rstd * gg.w + bb.w;
        }
      }
    }
#pragma unroll
    for (int r = 0; r < 2; ++r) {
#pragma unroll
      for (int i = 0; i < 4; ++i) *(float4*)(xr[r] + i * 256 + lane * 4) = v[r][i];
      if (H) {
#pragma unroll
        for (int i = 0; i < 4; ++i) {
          const float4 sh = shv[i], sc = scv[i];
          uint2 w;
          w.x = pack2(v[r][i].x * (1.f + sc.x) + sh.x, v[r][i].y * (1.f + sc.y) + sh.y);
          w.y = pack2(v[r][i].z * (1.f + sc.z) + sh.z, v[r][i].w * (1.f + sc.w) + sh.w);
          *(uint2*)(H + (size_t)(row0 + r) * 1024 + i * 256 + lane * 4) = w;
        }
      }
    }
  }
#undef ROWS_FETCH
}

__device__ __forceinline__ void convert_mat(const float* W, int K, int N, bf16_t* Wt, int perm, const float* rs, char* smem) {
  float* tile = (float*)smem;
  const int tid = tidx(), tx = tid & 31, ty = tid >> 5;
  const int nkt = K / 64, nnt = N / 32, ntile = nkt * nnt;
  for (int ti = blockIdx.x; ti < ntile; ti += gridDim.x) {
    const int nt = ti % nnt, kt = ti / nnt;
    const int n0 = nt * 32, k0 = kt * 64;
    __syncthreads();
#pragma unroll
    for (int i = 0; i < 2; ++i) {
      const int kr = (tid >> 3) + 32 * i, k = k0 + kr, c4 = (tid & 7) * 4;
      float4 v = *(const float4*)(W + (size_t)k * N + n0 + c4);
      if (rs) { const float g = rs[k]; v.x *= g; v.y *= g; v.z *= g; v.w *= g; }
      float* tp = tile + kr * 33 + c4;
      tp[0] = v.x; tp[1] = v.y; tp[2] = v.z; tp[3] = v.w;
    }
    __syncthreads();
    int d0 = n0;
    if (perm == 1) d0 = (n0 < 4096) ? n0 : (n0 < 4128 ? C_KR + (n0 - 4096) : n0 - 32);
#pragma unroll
    for (int i = 0; i < 4; ++i) {
      const int nn = ty + 8 * i;
      *(unsigned*)(Wt + (size_t)(d0 + nn) * K + k0 + 2 * tx) = pack2(tile[(2 * tx) * 33 + nn], tile[(2 * tx + 1) * 33 + nn]);
    }
  }
}


__device__ __forceinline__ void convert_layer(const Params& p, int l, char* smem) {
  const int G = gridDim.x, bid = blockIdx.x;
  char* wt = WS(p) + OFF_WT;
  convert_mat(p.w_in + (size_t)l * 1024 * INW, 1024, INW, (bf16_t*)(wt + WT_IN), 1, nullptr, smem);
  {
    uint4* z = (uint4*)(wt + WT_IN + (size_t)INW * 1024 * 2);
    const uint4 zz = {0u, 0u, 0u, 0u};
    for (int i = bid * 256 + tidx(); i < (NP - INW) * 1024 * 2 / 16; i += G * 256) z[i] = zz;
  }
  convert_mat(p.mla_w_qup + (size_t)l * 256 * 768, 256, 768, (bf16_t*)(wt + WT_QUP), 0, p.mla_q_norm + l * 256, smem);
  convert_mat(p.mla_w_kvup + (size_t)l * 256 * 1024, 256, 1024, (bf16_t*)(wt + WT_KVUP), 0, p.mla_kv_norm + l * 256, smem);
  convert_mat(p.w_br_ret + (size_t)l * 512 * 1024, 512, 1024, (bf16_t*)(wt + WT_BR), 0, nullptr, smem);
  convert_mat(p.w_br_na + (size_t)l * 512 * 1024, 512, 1024, (bf16_t*)(wt + WT_BR + (size_t)1024 * 512 * 2), 0, nullptr, smem);
  convert_mat(p.w_br_mla + (size_t)l * 512 * 1024, 512, 1024, (bf16_t*)(wt + WT_BR + (size_t)2 * 1024 * 512 * 2), 0, nullptr, smem);
  convert_mat(p.w_out + (size_t)l * 1024 * 1024, 1024, 1024, (bf16_t*)(wt + WT_OUT), 0, nullptr, smem);
  convert_mat(p.w_ff1 + (size_t)l * 1024 * 4096, 1024, 4096, (bf16_t*)(wt + WT_FF1), 0, nullptr, smem);
  convert_mat(p.w_ff2 + (size_t)l * 4096 * 1024, 4096, 1024, (bf16_t*)(wt + WT_FF2), 0, nullptr, smem);
}

__device__ __forceinline__ void phase_init(const Params& p, char* smem) {
  const int tid = tidx();
  {
    float* T64c = (float*)(WS(p) + OFF_TAB);
    float* T64s = T64c + 128 * 16;
    float* T32c = T64s + 128 * 16;
    float* T32s = T32c + 128 * 8;
    for (int i = blockIdx.x * 256 + tid; i < 128 * 16 + 128 * 8; i += gridDim.x * 256) {
      if (i < 128 * 16) {
        const int pp = i >> 4, f = i & 15;
        const float inv = powf(10000.f, -(float)f / 16.f);
        const float ang = (float)pp * inv;
        T64c[i] = cosf(ang); T64s[i] = sinf(ang);
      } else {
        const int k = i - 128 * 16, pp = k >> 3, f = k & 7;
        const float inv = powf(10000.f, -(float)f / 8.f);
        const float ang = (float)pp * inv;
        T32c[k] = cosf(ang); T32s[k] = sinf(ang);
      }
    }
  }
  float* sc = (float*)smem;
  float* red = sc + 3 * 1024;
  for (int i = tid; i < 3 * 1024; i += 256) {
    const int v = i >> 10, k = i & 1023;
    const float cv = v < 2 ? p.c[v * 1024 + k] : p.c_ctx[k];
    sc[i] = cv / (1.f + __expf(-cv));
  }
  __syncthreads();
  float* MOD = (float*)(WS(p) + OFF_MOD);
  const int c4 = tid & 7, kg = tid >> 3;
  for (int u = blockIdx.x; u < DEPTH * 192; u += gridDim.x) {
    const int l = u / 192, n0 = (u % 192) * 32;
    const float* W = p.w_ada + (size_t)l * 1024 * 6144 + n0 + c4 * 4;
    float4 a0 = {0.f, 0.f, 0.f, 0.f}, a1 = a0, a2 = a0;
#pragma unroll 16
    for (int k = kg * 32; k < kg * 32 + 32; ++k) {
      const float4 w = *(const float4*)(W + (size_t)k * 6144);
      const float s0 = sc[k], s1 = sc[1024 + k], s2 = sc[2048 + k];
      a0.x += s0 * w.x; a0.y += s0 * w.y; a0.z += s0 * w.z; a0.w += s0 * w.w;
      a1.x += s1 * w.x; a1.y += s1 * w.y; a1.z += s1 * w.z; a1.w += s1 * w.w;
      a2.x += s2 * w.x; a2.y += s2 * w.y; a2.z += s2 * w.z; a2.w += s2 * w.w;
    }
    __syncthreads();
    *(float4*)(red + (kg * 3 + 0) * 32 + c4 * 4) = a0;
    *(float4*)(red + (kg * 3 + 1) * 32 + c4 * 4) = a1;
    *(float4*)(red + (kg * 3 + 2) * 32 + c4 * 4) = a2;
    __syncthreads();
    if (tid < 96) {
      const int v = tid >> 5, cc = tid & 31;
      float s = p.b_ada[l * 6144 + n0 + cc];
#pragma unroll
      for (int g = 0; g < 32; ++g) s += red[(g * 3 + v) * 32 + cc];
      MOD[(size_t)(l * 3 + v) * 6144 + n0 + cc] = s;
    }
  }
}


#define XB_TMO      128
#define XB_XCNT(j)  (256  + 64 * (j))
#define XB_XSUB(j)  (1280 + 64 * (j))
#define XB_XGEN(j)  (2304 + 64 * (j))
#define XB_TOP      3328
#define XB_TOPGEN   3392
#define XCD_BAR_WORDS 3456
#define XB_SPIN_CAP (1u << 20)
__device__ __forceinline__ unsigned xb_ld(unsigned* p) { return __hip_atomic_load(p, __ATOMIC_RELAXED, __HIP_MEMORY_SCOPE_AGENT); }
__device__ __forceinline__ unsigned xb_add(unsigned* p, unsigned v) { return __hip_atomic_fetch_add(p, v, __ATOMIC_RELAXED, __HIP_MEMORY_SCOPE_AGENT); }
__device__ __forceinline__ unsigned xb_xcc_id() { return (unsigned)__builtin_amdgcn_s_getreg((3 << 11) | 20) & 0xFu; }
#define XB_SPIN(cond, bar) do { unsigned _sp = 0; while (cond) { __builtin_amdgcn_s_sleep(1); \
    if ((++_sp & 255u) == 0u) { if (xb_ld(&(bar)[XB_TMO])) break; if (_sp > XB_SPIN_CAP) { atomicAdd(&(bar)[XB_TMO], 1u); break; } } } } while (0)
struct XcdBarrier { unsigned* bar; unsigned x; volatile AS3 unsigned* st; };
__device__ __forceinline__ XcdBarrier xcd_barrier_post(unsigned* bar, volatile AS3 unsigned* st) {
  XcdBarrier b; b.bar = bar; b.x = xb_xcc_id(); b.st = st;
  if (threadIdx.x == 0) (void)xb_add(&bar[XB_XCNT(b.x)], 1u);
  return b;
}
__device__ __forceinline__ void xcd_barrier_complete(unsigned* bar, unsigned x, unsigned& nloc, unsigned& nx) {
  const unsigned G = gridDim.x * gridDim.y * gridDim.z;
  unsigned sum, cnt, mine, sp = 0u;
  for (;;) {
    sum = 0u; cnt = 0u; mine = 0u;
#pragma unroll
    for (unsigned j = 0; j < 16; ++j) { const unsigned c = xb_ld(&bar[XB_XCNT(j)]); sum += c; cnt += (c > 0u) ? 1u : 0u; mine = (j == x) ? c : mine; }
    if (sum == G) break;
    __builtin_amdgcn_s_sleep(1);
    if ((++sp & 255u) == 0u) { if (xb_ld(&bar[XB_TMO])) break; if (sp > XB_SPIN_CAP) { atomicAdd(&bar[XB_TMO], 1u); break; } }
  }
  nloc = mine > 0u ? mine : 1u; nx = cnt > 0u ? cnt : 1u;
}
__device__ __forceinline__ void xcd_barrier(const XcdBarrier& b) {
  asm volatile("s_waitcnt vmcnt(0)" ::: "memory");
  __syncthreads();
  if (threadIdx.x == 0) {
    unsigned* bar = b.bar;
    __builtin_amdgcn_s_waitcnt(0);
    unsigned nloc = b.st[0], nx = b.st[1];
    if (nloc == 0u) { xcd_barrier_complete(bar, b.x, nloc, nx); b.st[0] = nloc; b.st[1] = nx; }
    const unsigned old = xb_add(&bar[XB_XSUB(b.x)], 1u);
    const unsigned gen = old / nloc;
    if (old + 1u == (gen + 1u) * nloc) {
      __builtin_amdgcn_fence(__ATOMIC_RELEASE, "agent");
      asm volatile("s_waitcnt vmcnt(0)" ::: "memory");
      const unsigned og = xb_add(&bar[XB_TOP], 1u);
      const unsigned tg = og / nx;
      if (og + 1u == (tg + 1u) * nx) xb_add(&bar[XB_TOPGEN], 1u);
      else XB_SPIN(xb_ld(&bar[XB_TOPGEN]) == tg, bar);
      __builtin_amdgcn_fence(__ATOMIC_ACQUIRE, "agent");
      xb_add(&bar[XB_XGEN(b.x)], 1u);
      asm volatile("s_waitcnt vmcnt(0)" ::: "memory");
    } else {
      XB_SPIN(xb_ld(&bar[XB_XGEN(b.x)]) == gen, bar);
      __builtin_amdgcn_fence(__ATOMIC_ACQUIRE, "agent");
      asm volatile("s_waitcnt vmcnt(0)" ::: "memory");
    }
  }
  __syncthreads();
}

constexpr int NPHASE = 1 + DEPTH * 10 + 1;
#ifndef ONLY
#define ONLY -1
#endif
#ifndef PROBE_MASK
#define PROBE_MASK 0x0
#endif
#ifndef PROBE_SYNC
#define PROBE_SYNC 0
#endif

__global__ void __launch_bounds__(256, 2) mega_kernel(Params p, int ph_lo, int ph_hi) {
  __shared__ __attribute__((aligned(16))) char smem[SMEM_BYTES + 16];
  cg::grid_group grid = cg::this_grid();
  volatile AS3 unsigned* xst = (volatile AS3 unsigned*)(smem + SMEM_BYTES);
  if (threadIdx.x == 0) { xst[0] = 0u; xst[1] = 0u; }
  __syncthreads();
  const XcdBarrier xb = xcd_barrier_post((unsigned*)(p.ws + OFF_BAR), xst);
  const int G = gridDim.x, bid = blockIdx.x;
  for (int ph = ph_lo; ph < ph_hi; ++ph) {
    if (ph == 0) {
      if (ONLY < 0 || ONLY == 10) { phase_init(p, smem); __syncthreads(); convert_layer(p, 0, smem); }
    } else if (ph == NPHASE - 1) {
      rows_phase(p, false, (const bf16_t*)(WS(p) + OFF_D), DEPTH - 1, 5, p.ln_gain + ((DEPTH - 1) * 2 + 1) * 1024,
                 p.ln_bias + ((DEPTH - 1) * 2 + 1) * 1024, 0, 0, nullptr);
    } else {
      const int l = (ph - 1) / 10, sp = (ph - 1) % 10;
      const int reps = ((PROBE_MASK >> sp) & 1) ? 2 : 1;
      for (int rep = 0; rep < reps; ++rep)
      switch (sp) {
        case 0: if (ONLY < 0 || ONLY == 0) {
          if (rep == 0) {
          if (l == 0) rows_phase(p, true, nullptr, 0, 0, nullptr, nullptr, 0, 0, (bf16_t*)(WS(p) + OFF_D));
          else rows_phase(p, false, (const bf16_t*)(WS(p) + OFF_D), l - 1, 5, p.ln_gain + ((l - 1) * 2 + 1) * 1024,
                          p.ln_bias + ((l - 1) * 2 + 1) * 1024, l, 0, (bf16_t*)(WS(p) + OFF_D));
          }
          if (l > 0) convert_layer(p, l, smem);
        } break;
        case 1: if (ONLY < 0 || ONLY == 1) {
          TileOrder to; to.init(MROWS / 128, NP / 128, bid & 7, 0);
          const int nslot = (G + 7 - (bid & 7)) >> 3;
          int i = bid >> 3, brow, pn, nm;
          if (i < to.total) { to.get(i, brow, pn, nm); __syncthreads(); gemm_prefetch0(job_win(p, brow >> 7, pn), smem); }
          for (; i < to.total; i += nslot) {
            to.get(i, brow, pn, nm);
            GemmJob nx{}; const bool hn = i + nslot < to.total;
            if (hn) { int b2, pn2, nm2; to.get(i + nslot, b2, pn2, nm2); nx = job_win(p, b2 >> 7, pn2); }
            tile_win(p, brow >> 7, pn, smem, nx, hn);
          }
        } break;
        case 2: if (ONLY < 0 || ONLY == 2) {
          constexpr int nM = MROWS / 128;
          constexpr int n_q = nM * 6, n_kv = nM * 8, n_r = 2 * 4 * NCHUNK;
          auto upjob = [&](int ti) { return ti < n_q ? job_up<true>(p, ti % nM, ti / nM) : job_up<false>(p, (ti - n_q) % nM, (ti - n_q) / nM); };
          if (bid < n_q + n_kv) { __syncthreads(); gemm_prefetch0(upjob(bid), smem); }
          for (int ti = bid; ti < n_q + n_kv + n_r; ti += G) {
            GemmJob nx{}; const bool hn = ti + G < n_q + n_kv;
            if (hn) nx = upjob(ti + G);
            if (ti < n_q) tile_up<true>(p, ti % nM, ti / nM, smem, nx, hn);
            else if (ti < n_q + n_kv) tile_up<false>(p, (ti - n_q) % nM, (ti - n_q) / nM, smem, nx, hn);
            else tile_retkv(p, l, ti - n_q - n_kv, smem);
          }
        } break;
        case 3: if (ONLY < 0 || ONLY == 3) {
          constexpr int n_s = 512;
          for (int ti = bid; ti < n_s; ti += G) { if (rep == 0) unit_scan(p, l, ti); }
          const int xcd = bid & 7, slot = bid >> 3, nslot = (G + 7 - xcd) >> 3;
          for (int k = 0; k < 2; ++k)
            for (int qt = slot; qt < 64; qt += nslot) tile_mla(p, (xcd + 8 * k) * 66 + qt, smem);
        } break;
        case 4: if (ONLY < 0 || ONLY == 4) {
          const int xcd = bid & 7;
          for (int ti = bid; ti < 2 * 4 * NCHUNK * 2; ti += G) tile_retout(p, l, ti, smem);
          if (rep == 0) {
            unsigned* qw = (unsigned*)(WS(p) + OFF_BAR) + l * 8 + xcd;
            volatile AS3 unsigned* tk = (volatile AS3 unsigned*)(smem + SMEM_BYTES + 12);
            for (;;) {
              __syncthreads();
              if (tidx() == 0) *tk = __hip_atomic_fetch_add(qw, 1u, __ATOMIC_RELAXED, __HIP_MEMORY_SCOPE_AGENT);
              __syncthreads();
              const unsigned t = *tk;
              if (t >= 128u) break;
              tile_na(p, l, (xcd + 8 * (int)(t >> 6)) * 66 + (int)(t & 63u), smem);
            }
          } else {
            const int slot = bid >> 3, nslot = (G + 7 - xcd) >> 3;
            for (int k = 0; k < 2; ++k)
              for (int qt = slot; qt < 64; qt += nslot) tile_na(p, l, (xcd + 8 * k) * 66 + qt, smem);
          }
          for (int i = (G - 1 - bid); i < 64; i += G) {
            if (i < 32) tile_na(p, l, (i >> 1) * 66 + 64 + (i & 1), smem);
            else tile_mla(p, ((i - 32) >> 1) * 66 + 64 + (i & 1), smem);
          }
        } break;
        case 5: if (ONLY < 0 || ONLY == 5) {
          TileOrder to; to.init(MROWS / 128, 8, bid & 7, 1);
          const int nslot = (G + 7 - (bid & 7)) >> 3;
          int i = bid >> 3, brow, pn, nm;
          if (i < to.total) { to.get(i, brow, pn, nm); __syncthreads(); gemm_prefetch0(job_merge(p, brow, pn, 0, nm), smem); }
          for (; i < to.total; i += nslot) {
            to.get(i, brow, pn, nm);
            GemmJob nx{}; const bool hn = i + nslot < to.total;
            if (hn) { int b2, pn2, nm2; to.get(i + nslot, b2, pn2, nm2); nx = job_merge(p, b2, pn2, 0, nm2); }
            if (nm == 4) tile_merge<4>(p, brow, pn, smem, nx, hn); else tile_merge<1>(p, brow, pn, smem, nx, hn);
          }
        } break;
        case 6: if (ONLY < 0 || ONLY == 6) {
          TileOrder to; to.init(MROWS / 128, 8, bid & 7, 1);
          const int nslot = (G + 7 - (bid & 7)) >> 3;
          const bf16_t* pa = (const bf16_t*)(WS(p) + OFF_E); const bf16_t* pw = (const bf16_t*)(WS(p) + OFF_WT + WT_OUT);
          bf16_t* po = (bf16_t*)(WS(p) + OFF_D);
          int i = bid >> 3, brow, pn, nm;
          if (i < to.total) { to.get(i, brow, pn, nm); __syncthreads(); gemm_prefetch0(job_plain(pa, 1024, pw, 1024, brow, pn, nm), smem); }
          for (; i < to.total; i += nslot) {
            to.get(i, brow, pn, nm);
            GemmJob nx{}; const bool hn = i + nslot < to.total;
            if (hn) { int b2, pn2, nm2; to.get(i + nslot, b2, pn2, nm2); nx = job_plain(pa, 1024, pw, 1024, b2, pn2, nm2); }
            if (nm == 4) tile_plain<0, 4>(pa, 1024, pw, 1024, po, 1024, brow, pn, smem, nx, hn);
            else tile_plain<0, 1>(pa, 1024, pw, 1024, po, 1024, brow, pn, smem, nx, hn);
          }
        } break;
        case 7: if (ONLY < 0 || ONLY == 7) {
          if (rep == 0) rows_phase(p, false, (const bf16_t*)(WS(p) + OFF_D), l, 2, p.ln_gain + (l * 2) * 1024, p.ln_bias + (l * 2) * 1024, l, 3,
                     (bf16_t*)(WS(p) + OFF_E));
        } break;
        case 8: if (ONLY < 0 || ONLY == 8) {
          TileOrder to; to.init(MROWS / 128, 32, bid & 7, 1);
          const int nslot = (G + 7 - (bid & 7)) >> 3;
          const bf16_t* pa = (const bf16_t*)(WS(p) + OFF_E); const bf16_t* pw = (const bf16_t*)(WS(p) + OFF_WT + WT_FF1);
          bf16_t* po = (bf16_t*)(WS(p) + OFF_P);
          int i = bid >> 3, brow, pn, nm;
          if (i < to.total) { to.get(i, brow, pn, nm); __syncthreads(); gemm_prefetch0(job_plain(pa, 1024, pw, 1024, brow, pn, nm), smem); }
          for (; i < to.total; i += nslot) {
            to.get(i, brow, pn, nm);
            GemmJob nx{}; const bool hn = i + nslot < to.total;
            if (hn) { int b2, pn2, nm2; to.get(i + nslot, b2, pn2, nm2); nx = job_plain(pa, 1024, pw, 1024, b2, pn2, nm2); }
            if (nm == 4) tile_plain<1, 4>(pa, 1024, pw, 1024, po, 4096, brow, pn, smem, nx, hn);
            else tile_plain<1, 1>(pa, 1024, pw, 1024, po, 4096, brow, pn, smem, nx, hn);
          }
        } break;
        case 9: if (ONLY < 0 || ONLY == 9) {
          TileOrder to; to.init(MROWS / 128, 8, bid & 7, 1);
          const int nslot = (G + 7 - (bid & 7)) >> 3;
          const bf16_t* pa = (const bf16_t*)(WS(p) + OFF_P); const bf16_t* pw = (const bf16_t*)(WS(p) + OFF_WT + WT_FF2);
          bf16_t* po = (bf16_t*)(WS(p) + OFF_D);
          int i = bid >> 3, brow, pn, nm;
          if (i < to.total) { to.get(i, brow, pn, nm); __syncthreads(); gemm_prefetch0(job_plain(pa, 4096, pw, 4096, brow, pn, nm), smem); }
          for (; i < to.total; i += nslot) {
            to.get(i, brow, pn, nm);
            GemmJob nx{}; const bool hn = i + nslot < to.total;
            if (hn) { int b2, pn2, nm2; to.get(i + nslot, b2, pn2, nm2); nx = job_plain(pa, 4096, pw, 4096, b2, pn2, nm2); }
            if (nm == 4) tile_plain<0, 4>(pa, 4096, pw, 4096, po, 1024, brow, pn, smem, nx, hn);
            else tile_plain<0, 1>(pa, 4096, pw, 4096, po, 1024, brow, pn, smem, nx, hn);
          }
        } break;
      }
    }
    if (ph + 1 < ph_hi) {
      if (ph_lo < 0) grid.sync();
      xcd_barrier(xb);
    }
  }
}

#ifndef ONE_LAUNCH
#define ONE_LAUNCH 1
#endif

extern "C" void kernel_launch(void* const* d_in, const int* in_sizes, int n_in, void* d_out, int out_size, void* d_ws, size_t ws_size,
                              hipStream_t stream) {
  static int grid_blocks = 0;
  if (!grid_blocks) {
    int dev = 0, cus = 0, per_cu = 0;
    hipGetDevice(&dev);
    hipDeviceGetAttribute(&cus, hipDeviceAttributeMultiprocessorCount, dev);
    hipOccupancyMaxActiveBlocksPerMultiprocessor(&per_cu, mega_kernel, 256, 0);
    if (per_cu > 2) per_cu = 2;
    grid_blocks = cus * per_cu;
  }
  if (ws_size < WS_NEED) { fprintf(stderr, "workspace too small: %zu < %zu\n", ws_size, (size_t)WS_NEED); return; }
  Params p{};
  const float** pp = (const float**)&p;
  for (int i = 0; i < 22; ++i) pp[i] = (const float*)d_in[i];
  p.out = (float*)d_out;
  p.ws = (char*)d_ws;
  hipMemsetAsync((char*)d_ws + OFF_BAR, 0, 16384, stream);
#if ONE_LAUNCH
  int lo = 0, hi = NPHASE;
  void* args[] = {&p, &lo, &hi};
  hipError_t e = hipLaunchCooperativeKernel((void*)mega_kernel, dim3(grid_blocks), dim3(256), args, 0, stream);
  if (e != hipSuccess) fprintf(stderr, "cooperative launch failed: %s (grid %d)\n", hipGetErrorString(e), grid_blocks);
#else
  for (int ph = 0; ph < NPHASE; ++ph) {
    int lo = ph, hi = ph + 1;
    void* args[] = {&p, &lo, &hi};
    hipError_t e = hipLaunchCooperativeKernel((void*)mega_kernel, dim3(grid_blocks), dim3(256), args, 0, stream);
    if (e != hipSuccess) fprintf(stderr, "launch failed: %s\n", hipGetErrorString(e));
  }
#endif
}
```

```cpp
#include <hip/hip_runtime.h>
#include <hip/hip_cooperative_groups.h>
#include <cstdio>
#include <cstdint>
namespace cg = cooperative_groups;

typedef unsigned short bf16_t;
typedef short bf16x8 __attribute__((ext_vector_type(8)));
typedef short s16x4 __attribute__((ext_vector_type(4)));
typedef float f32x4 __attribute__((ext_vector_type(4)));
#define AS3 __attribute__((address_space(3)))

constexpr int D = 1024, SEQ = 8192, CTX = 256, TB = SEQ + CTX, MROWS = 2 * TB;
constexpr int DEPTH = 4, INW = 7200, NP = 7296;
constexpr int NCHUNK = TB / 128;
constexpr int C_RQ = 0, C_RK = 256, C_RV = 512, C_GF = 1024, C_GB = 1536, C_NQ = 2048, C_NK = 2560, C_NV = 3072,
              C_MQD = 3584, C_MKVD = 3840, C_GATE = 4096, C_KR = 7168;
constexpr float LOG2E = 1.4426950408889634f;
constexpr float ALPHA = 1.681792830507429f;
constexpr float EPS = 1e-5f;

constexpr size_t SZ_P = (size_t)MROWS * NP * 2;
constexpr size_t WT_IN = 0, WT_QUP = WT_IN + (size_t)NP * 1024 * 2, WT_KVUP = WT_QUP + 768 * 256 * 2,
                 WT_BR = WT_KVUP + 1024 * 256 * 2, WT_OUT = WT_BR + 3 * (size_t)1024 * 512 * 2,
                 WT_FF1 = WT_OUT + (size_t)1024 * 1024 * 2, WT_FF2 = WT_FF1 + (size_t)4096 * 1024 * 2,
                 SZ_WT = WT_FF2 + (size_t)1024 * 4096 * 2;
constexpr size_t SZ_Z = (size_t)2 * CTX * D * 4;
constexpr size_t SZ_D = (size_t)MROWS * 1024 * 2;
constexpr size_t SZ_QM = (size_t)MROWS * 768 * 2, SZ_KVM = (size_t)MROWS * 1024 * 2;
constexpr size_t SZ_YC = (size_t)MROWS * 512 * 2;
constexpr size_t SZ_ST = (size_t)2 * 2 * 4 * NCHUNK * 8192 * 4;
constexpr size_t SZ_MOD = (size_t)DEPTH * 3 * 6144 * 4;
constexpr size_t SZ_TAB = (size_t)(2 * 128 * 16 + 2 * 128 * 8) * 4;
constexpr size_t OFF_P = 0, OFF_WT = OFF_P + SZ_P, OFF_Z = OFF_WT + SZ_WT, OFF_D = OFF_Z + SZ_Z, OFF_E = OFF_D + SZ_D,
                 OFF_YC = OFF_E + SZ_QM + SZ_KVM, OFF_ST = OFF_YC + SZ_YC, OFF_MOD = OFF_ST + SZ_ST, OFF_TAB = OFF_MOD + SZ_MOD,
                 OFF_BAR = OFF_TAB + SZ_TAB, WS_NEED = OFF_BAR + 16384;

constexpr int SMEM_BYTES = 65536 + 512;

struct Params {
  const float *x, *c, *ctx, *c_ctx, *w_ada, *b_ada, *w_in, *ret_log_decay, *ret_gn_gain, *na_rpb, *mla_q_norm, *mla_w_qup,
      *mla_kv_norm, *mla_w_kvup, *w_br_ret, *w_br_na, *w_br_mla, *w_out, *w_ff1, *w_ff2, *ln_gain, *ln_bias;
  float* out;
  char* ws;
};

typedef __bf16 bf2_t __attribute__((ext_vector_type(2)));
typedef float f2_t __attribute__((ext_vector_type(2)));
__device__ __forceinline__ bf16_t f2bf(float f) { return __builtin_bit_cast(unsigned short, (__bf16)f); }
__device__ __forceinline__ float bf2f(bf16_t h) { return __uint_as_float(((unsigned)h) << 16); }
__device__ __forceinline__ unsigned pack2(float lo, float hi) {
  f2_t v = {lo, hi};
  return __builtin_bit_cast(unsigned, __builtin_convertvector(v, bf2_t));
}
__device__ __forceinline__ float bflo(unsigned u) { return __uint_as_float(u << 16); }
__device__ __forceinline__ float bfhi(unsigned u) { return __uint_as_float(u & 0xffff0000u); }
__device__ __forceinline__ s16x4 tr_read(const bf16_t* p) { return __builtin_amdgcn_ds_read_tr16_b64_v4i16((AS3 s16x4*)p); }
__device__ __forceinline__ f32x4 mfma16(bf16x8 a, bf16x8 b, f32x4 c) { return __builtin_amdgcn_mfma_f32_16x16x32_bf16(a, b, c, 0, 0, 0); }
__device__ __forceinline__ char* WS(const Params& p) { size_t z = 0; asm volatile("" : "+s"(z)); return p.ws + z; }
__device__ __forceinline__ int tidx() { int t = threadIdx.x; asm volatile("" : "+v"(t)); return t; }
__device__ __forceinline__ float* xrow_ptr(const Params& p, int row) {
  int b = row / TB, t = row - b * TB;
  return t < CTX ? (float*)(WS(p) + OFF_Z) + (size_t)(b * CTX + t) * D : p.out + ((size_t)b * SEQ + (t - CTX)) * D;
}
__device__ __forceinline__ float fmax_nc(float a, float b) { return __builtin_amdgcn_fmed3f(a, b, 3.0e38f); }
typedef unsigned u32x2_t __attribute__((ext_vector_type(2)));
__device__ __forceinline__ float xmax16(float x) {
  const u32x2_t r = __builtin_amdgcn_permlane16_swap(__float_as_uint(x), __float_as_uint(x), false, false);
  return __builtin_amdgcn_fmed3f(__uint_as_float(r[0]), __uint_as_float(r[1]), 3.0e38f);
}
__device__ __forceinline__ float xmax32(float x) {
  const u32x2_t r = __builtin_amdgcn_permlane32_swap(__float_as_uint(x), __float_as_uint(x), false, false);
  return __builtin_amdgcn_fmed3f(__uint_as_float(r[0]), __uint_as_float(r[1]), 3.0e38f);
}
__device__ __forceinline__ float dpp_f(float v, const int ctrl_sel) {
  unsigned u = __float_as_uint(v), r;
  if (ctrl_sel == 0) r = __builtin_amdgcn_update_dpp(0u, u, 0xB1, 0xf, 0xf, false);
  else if (ctrl_sel == 1) r = __builtin_amdgcn_update_dpp(0u, u, 0x4E, 0xf, 0xf, false);
  else if (ctrl_sel == 2) r = __builtin_amdgcn_update_dpp(0u, u, 0x141, 0xf, 0xf, false);
  else r = __builtin_amdgcn_update_dpp(0u, u, 0x140, 0xf, 0xf, false);
  return __uint_as_float(r);
}
__device__ __forceinline__ float wave_sum(float v) {
  v += dpp_f(v, 0);
  v += dpp_f(v, 1);
  v += dpp_f(v, 2);
  v += dpp_f(v, 3);
  { const u32x2_t r = __builtin_amdgcn_permlane16_swap(__float_as_uint(v), __float_as_uint(v), false, false); v = __uint_as_float(r[0]) + __uint_as_float(r[1]); }
  { const u32x2_t r = __builtin_amdgcn_permlane32_swap(__float_as_uint(v), __float_as_uint(v), false, false); v = __uint_as_float(r[0]) + __uint_as_float(r[1]); }
  return v;
}
__device__ __forceinline__ float xadd16(float v) { const u32x2_t r = __builtin_amdgcn_permlane16_swap(__float_as_uint(v), __float_as_uint(v), false, false); return __uint_as_float(r[0]) + __uint_as_float(r[1]); }
__device__ __forceinline__ float xadd32(float v) { const u32x2_t r = __builtin_amdgcn_permlane32_swap(__float_as_uint(v), __float_as_uint(v), false, false); return __uint_as_float(r[0]) + __uint_as_float(r[1]); }
__device__ __forceinline__ float half_sum32(float v) {
  v += dpp_f(v, 0); v += dpp_f(v, 1); v += dpp_f(v, 2); v += dpp_f(v, 3);
  return xadd16(v);
}
__device__ __forceinline__ float sigmoidf_(float v) { return __builtin_amdgcn_rcpf(1.f + __builtin_amdgcn_exp2f(-LOG2E * v)); }

struct GemmJob { const bf16_t* A; const bf16_t* Bt; int lda, ldb, K, brow, bcol, nm; };
template <int NM>
__device__ __forceinline__ void gemm_issue(const GemmJob& j, int t, int buf, char* smem, int tid) {
  const int cel = ((tid & 7) ^ ((tid >> 3) & 7)) * 8;
  const int r0 = tid >> 3;
  char* sb = smem + buf * 32768 + tid * 16;
  const bf16_t* pa = j.A + (size_t)(j.brow + r0) * j.lda + cel + t * 64;
  const bf16_t* pb = j.Bt + (size_t)(j.bcol + r0) * j.ldb + cel + t * 64;
  const size_t a32 = (size_t)32 * j.lda, b32 = (size_t)32 * j.ldb;
  if (NM == 4) {
#pragma unroll
    for (int i = 0; i < 4; ++i)
      __builtin_amdgcn_global_load_lds((const unsigned*)(pa + i * a32), (AS3 unsigned*)(sb + i * 4096), 16, 0, 0);
  } else {
    __builtin_amdgcn_global_load_lds((const unsigned*)pa, (AS3 unsigned*)sb, 16, 0, 0);
  }
#pragma unroll
  for (int i = 0; i < 4; ++i)
    __builtin_amdgcn_global_load_lds((const unsigned*)(pb + i * b32), (AS3 unsigned*)(sb + 16384 + i * 4096), 16, 0, 0);
}
__device__ __forceinline__ void gemm_prefetch0(const GemmJob& j, char* smem) {
  if (j.nm == 4) gemm_issue<4>(j, 0, 0, smem, tidx()); else gemm_issue<1>(j, 0, 0, smem, tidx());
}
template <int NM>
__device__ __forceinline__ void gemm_run(const GemmJob& j, char* smem, f32x4 (&acc)[NM][4]) {
  const int tid = tidx(), wid = tid >> 6, lane = tid & 63, wr = wid >> 1, wc = wid & 1, fr = lane & 15, fq = lane >> 4;
  const int foff0 = fr * 128 + ((fq ^ (fr & 7)) << 4);
  const int foff1 = fr * 128 + (((4 + fq) ^ (fr & 7)) << 4);
  const int nt = j.K >> 6;
#pragma unroll 1
  for (int t = 0; t < nt; ++t) {
    if (t + 1 < nt) {
      gemm_issue<NM>(j, t + 1, (t + 1) & 1, smem, tid);
      if (NM == 4) asm volatile("s_waitcnt vmcnt(8)" ::: "memory");
      else asm volatile("s_waitcnt vmcnt(5)" ::: "memory");
    } else {
      asm volatile("s_waitcnt vmcnt(0)" ::: "memory");
    }
    __builtin_amdgcn_s_barrier();
    const char* sA = smem + (t & 1) * 32768;
    const char* sB = sA + 16384;
    bf16x8 af[2][NM], bfr[2][4];
#pragma unroll
    for (int kh = 0; kh < 2; ++kh) {
      const int fo = kh ? foff1 : foff0;
#pragma unroll
      for (int n = 0; n < 4; ++n) bfr[kh][n] = *(const bf16x8*)(sB + (wc * 64 + n * 16) * 128 + fo);
#pragma unroll
      for (int m = 0; m < NM; ++m) af[kh][m] = *(const bf16x8*)(sA + (wr * 16 * NM + m * 16) * 128 + fo);
    }
    __builtin_amdgcn_sched_barrier(0);
#pragma unroll
    for (int kh = 0; kh < 2; ++kh)
#pragma unroll
      for (int m = 0; m < NM; ++m)
#pragma unroll
        for (int n = 0; n < 4; ++n) acc[m][n] = mfma16(bfr[kh][n], af[kh][m], acc[m][n]);
    __builtin_amdgcn_sched_barrier(0);
    asm volatile("s_waitcnt lgkmcnt(0)" ::: "memory");
    __builtin_amdgcn_s_barrier();
  }
}
template <int NM>
__device__ __forceinline__ void zero_acc(f32x4 (&acc)[NM][4]) {
#pragma unroll
  for (int m = 0; m < NM; ++m)
#pragma unroll
    for (int n = 0; n < 4; ++n) acc[m][n] = (f32x4){0.f, 0.f, 0.f, 0.f};
}
__device__ __forceinline__ void store4(bf16_t* dst, f32x4 v) {
  uint2 w; w.x = pack2(v[0], v[1]); w.y = pack2(v[2], v[3]);
  *(uint2*)dst = w;
}


template <int NM>
__device__ __forceinline__ void store_tile_lds(const f32x4 (&v)[NM][4], bf16_t* O, size_t ldo, int brow, int bcol, char* smem) {
  const int tid = tidx(), wid = tid >> 6, lane = tid & 63, wr = wid >> 1, wc = wid & 1, fr = lane & 15, fq = lane >> 4;
  char* C = smem + 32768;
#pragma unroll
  for (int m = 0; m < NM; ++m) {
    const int rl = wr * 16 * NM + m * 16 + fr;
#pragma unroll
    for (int n = 0; n < 4; ++n) {
      const int cc = wc * 8 + n * 2 + (fq >> 1);
      uint2 w; w.x = pack2(v[m][n][0], v[m][n][1]); w.y = pack2(v[m][n][2], v[m][n][3]);
      *(uint2*)(C + rl * 256 + ((cc ^ (rl & 15)) << 4) + ((fq & 1) << 3)) = w;
    }
  }
  asm volatile("s_waitcnt lgkmcnt(0)" ::: "memory");
  __builtin_amdgcn_s_barrier();
#pragma unroll
  for (int i = 0; i < 2 * NM; ++i) {
    const int id = tid + 256 * i, rl = id >> 4, c = id & 15;
    const uint4 w = *(const uint4*)(C + rl * 256 + ((c ^ (rl & 15)) << 4));
    *(uint4*)(O + (size_t)(brow + rl) * ldo + bcol + c * 8) = w;
  }
  asm volatile("s_waitcnt lgkmcnt(0)" ::: "memory");
  __builtin_amdgcn_s_barrier();
}

struct TileOrder {
  int nM, nN, x, npl, full, wlast, nmain, total, fine;
  __device__ __forceinline__ void init(int nM_, int nN_, int xcd, int fine_) {
    nM = nM_; nN = nN_; x = xcd; fine = fine_; npl = nM / 8; wlast = nN & 7; full = (nN >> 3) * npl * 8; nmain = npl * nN;
    const int nextra = (nM - npl * 8) * nN * (fine ? 4 : 1);
    total = nmain + (nextra + 7 - xcd) / 8;
  }
  __device__ __forceinline__ void get(int i, int& brow, int& pn, int& nm) const {
    nm = 4;
    if (i < full) { const int g = i / (npl * 8), r = i - g * (npl * 8); brow = ((r >> 3) * 8 + x) * 128; pn = g * 8 + (r & 7); }
    else if (i < nmain) { const int r = i - full; brow = ((r / wlast) * 8 + x) * 128; pn = (nN >> 3) * 8 + r % wlast; }
    else {
      const int e = (i - nmain) * 8 + x;
      if (fine) { brow = npl * 8 * 128 + (e / nN) * 32; nm = 1; } else brow = (npl * 8 + e / nN) * 128;
      pn = e % nN;
    }
  }
};


__device__ __forceinline__ GemmJob job_win(const Params& p, int pm, int pn) {
  GemmJob j; j.A = (const bf16_t*)(WS(p) + OFF_D); j.Bt = (const bf16_t*)(WS(p) + OFF_WT + WT_IN); j.lda = 1024; j.ldb = 1024; j.K = 1024;
  j.brow = pm * 128; j.bcol = pn * 128; j.nm = 4; return j;
}
__device__ __forceinline__ void tile_win(const Params& p, int pm, int pn, char* smem, const GemmJob next, const bool has_next) {
  const int tid = tidx(), wid = tid >> 6, lane = tid & 63, wr = wid >> 1, wc = wid & 1, fr = lane & 15, fq = lane >> 4;
  const bf16_t* Hx = (const bf16_t*)(WS(p) + OFF_D);
  const bf16_t* Wt = (const bf16_t*)(WS(p) + OFF_WT + WT_IN);
  bf16_t* P = (bf16_t*)(WS(p) + OFF_P);
  const float* T64c = (const float*)(WS(p) + OFF_TAB);
  const float* T64s = T64c + 128 * 16;
  const float* T32c = T64s + 128 * 16;
  const float* T32s = T32c + 128 * 8;
  f32x4 acc[4][4];
  zero_acc<4>(acc);
  const int brow = pm * 128, bcol = pn * 128;
  gemm_run<4>(job_win(p, pm, pn), smem, acc);
  const bool tabs = (bcol < 512) || (bcol == C_KR);
  if (has_next && !tabs) gemm_prefetch0(next, smem);
  const int cs = bcol + wc * 64;
#pragma unroll
  for (int m = 0; m < 4; ++m) {
    const int row = brow + wr * 64 + m * 16 + fr;
    const int t = row % TB;
    const bool isx = t >= CTX;
    const int pos = t - CTX, prow = pos >> 6, pcol = pos & 63;
    if (cs < 512) {
      if (isx) {
#pragma unroll
        for (int n = 0; n < 2; ++n) {
          const int pp = (n == 0) ? prow : pcol;
          const float4 cv4 = *(const float4*)(T64c + pp * 16 + fq * 4), sv4 = *(const float4*)(T64s + pp * 16 + fq * 4);
          const float cvv[4] = {cv4.x, cv4.y, cv4.z, cv4.w}, svv[4] = {sv4.x, sv4.y, sv4.z, sv4.w};
#pragma unroll
          for (int j = 0; j < 4; ++j) {
            const float cv = cvv[j], sv = svv[j];
            const float x1 = acc[m][n][j], x2 = acc[m][n + 2][j];
            acc[m][n][j] = x1 * cv - x2 * sv;
            acc[m][n + 2][j] = x1 * sv + x2 * cv;
          }
        }
      }
      if (cs >= 256) {
#pragma unroll
        for (int n = 0; n < 4; ++n) acc[m][n] = acc[m][n] * 0.125f;
      }
    } else if (cs >= C_NQ && cs < C_NQ + 512) {
#pragma unroll
      for (int n = 0; n < 4; ++n) acc[m][n] = acc[m][n] * (0.125f * LOG2E);
    } else if (cs == C_KR) {
      if (isx) {
        const int pp = (fq < 2) ? prow : pcol;
#pragma unroll
        for (int j = 0; j < 4; ++j) {
          const int f = (fq & 1) * 4 + j;
          const float cv = T32c[pp * 8 + f], sv = T32s[pp * 8 + f];
          const float x1 = acc[m][0][j], x2 = acc[m][1][j];
          acc[m][0][j] = x1 * cv - x2 * sv;
          acc[m][1][j] = x1 * sv + x2 * cv;
        }
      }
    }
  }
  if (has_next && tabs) { __builtin_amdgcn_sched_barrier(0); gemm_prefetch0(next, smem); }
  store_tile_lds<4>(acc, P, NP, brow, bcol, smem);
}

template <bool QUP>
__device__ __forceinline__ GemmJob job_up(const Params& p, int pm, int pn) {
  GemmJob j; j.A = (const bf16_t*)(WS(p) + OFF_P) + (QUP ? C_MQD : C_MKVD); j.Bt = (const bf16_t*)(WS(p) + OFF_WT + (QUP ? WT_QUP : WT_KVUP));
  j.lda = NP; j.ldb = 256; j.K = 256; j.brow = pm * 128; j.bcol = pn * 128; j.nm = 4; return j;
}
template <bool QUP>
__device__ __forceinline__ void tile_up(const Params& p, int pm, int pn, char* smem, const GemmJob next, const bool has_next) {
  const int tid = tidx(), wid = tid >> 6, lane = tid & 63, wr = wid >> 1, wc = wid & 1, fr = lane & 15, fq = lane >> 4;
  const bf16_t* P = (const bf16_t*)(WS(p) + OFF_P);
  const bf16_t* A = P + (QUP ? C_MQD : C_MKVD);
  const bf16_t* Wt = (const bf16_t*)(WS(p) + OFF_WT + (QUP ? WT_QUP : WT_KVUP));
  bf16_t* O = (bf16_t*)(WS(p) + OFF_E + (QUP ? 0 : SZ_QM));
  const int ldo = QUP ? 768 : 1024;
  const float* T32c = (const float*)(WS(p) + OFF_TAB) + 2 * 128 * 16;
  const float* T32s = T32c + 128 * 8;
  float* rr = (float*)(smem + 65536);
  const int brow = pm * 128, bcol = pn * 128;
  {
    const int lane = tid & 63, hw = lane >> 5, ch = lane & 31;
#pragma unroll 4
    for (int it = 0; it < 16; ++it) {
      const int r = (wid * 16 + it) * 2 + hw;
      const uint4 v = *(const uint4*)(A + (size_t)(brow + r) * NP + ch * 8);
      float a, ss = 0.f;
      a = bflo(v.x); ss += a * a; a = bfhi(v.x); ss += a * a;
      a = bflo(v.y); ss += a * a; a = bfhi(v.y); ss += a * a;
      a = bflo(v.z); ss += a * a; a = bfhi(v.z); ss += a * a;
      a = bflo(v.w); ss += a * a; a = bfhi(v.w); ss += a * a;
      ss = half_sum32(ss);
      if (ch == 0) rr[r] = rsqrtf(ss * (1.f / 256.f) + EPS);
    }
  }
  __syncthreads();
  f32x4 acc[4][4];
  zero_acc<4>(acc);
  gemm_run<4>(job_up<QUP>(p, pm, pn), smem, acc);
  if (has_next) gemm_prefetch0(next, smem);
  const int cs = bcol + wc * 64;
#pragma unroll
  for (int m = 0; m < 4; ++m) {
    const int rl = wr * 64 + m * 16 + fr, row = brow + rl;
    const float sc = QUP ? rr[rl] * (0.10206207261596575f * LOG2E) : rr[rl];
#pragma unroll
    for (int n = 0; n < 4; ++n) acc[m][n] = acc[m][n] * sc;
    if (QUP) {
      const int t = row % TB;
      if (t >= CTX) {
        const int pos = t - CTX, prow = pos >> 6, pcol = pos & 63;
        const int pp = (fq < 2) ? prow : pcol;
#pragma unroll
        for (int n = 0; n < 3; ++n) {
          if ((cs + n * 16) % 96 == 64) {
#pragma unroll
            for (int j = 0; j < 4; ++j) {
              const int f = (fq & 1) * 4 + j;
              const float cv = T32c[pp * 8 + f], sv = T32s[pp * 8 + f];
              const float x1 = acc[m][n][j], x2 = acc[m][n + 1][j];
              acc[m][n][j] = x1 * cv - x2 * sv;
              acc[m][n + 1][j] = x1 * sv + x2 * cv;
            }
          }
        }
      }
    }
  }
  store_tile_lds<4>(acc, O, ldo, brow, bcol, smem);
}

__device__ __forceinline__ GemmJob job_merge(const Params& p, int brow, int pn, int br, int nm) {
  GemmJob j;
  j.A = (br == 0) ? (const bf16_t*)(WS(p) + OFF_D) : (br == 1) ? (const bf16_t*)(WS(p) + OFF_D + SZ_YC) : (const bf16_t*)(WS(p) + OFF_YC);
  j.Bt = (const bf16_t*)(WS(p) + OFF_WT + WT_BR + (size_t)br * 1024 * 512 * 2);
  j.lda = 512; j.ldb = 512; j.K = 512; j.brow = brow; j.bcol = pn * 128; j.nm = nm; return j;
}
template <int NM>
__device__ __forceinline__ void tile_merge(const Params& p, int brow, int pn, char* smem, const GemmJob next, const bool has_next) {
  const int tid = tidx(), wid = tid >> 6, lane = tid & 63, wr = wid >> 1, wc = wid & 1, fr = lane & 15, fq = lane >> 4;
  const bf16_t* P = (const bf16_t*)(WS(p) + OFF_P);
  bf16_t* Y = (bf16_t*)(WS(p) + OFF_E);
  const int bcol = pn * 128, cs = bcol + wc * 64;
  f32x4 yacc[NM][4];
  zero_acc<NM>(yacc);
#pragma unroll 1
  for (int br = 0; br < 3; ++br) {
    f32x4 acc[NM][4];
    zero_acc<NM>(acc);
    gemm_run<NM>(job_merge(p, brow, pn, br, NM), smem, acc);
    uint2 gt[NM][4];
#pragma unroll
    for (int m = 0; m < NM; ++m) {
      const int row = brow + wr * 16 * NM + m * 16 + fr;
#pragma unroll
      for (int n = 0; n < 4; ++n) gt[m][n] = *(const uint2*)(P + (size_t)row * NP + C_GATE + br * 1024 + cs + n * 16 + fq * 4);
    }
    __builtin_amdgcn_sched_barrier(0);
    if (br < 2) gemm_prefetch0(job_merge(p, brow, pn, br + 1, NM), smem);
    else if (has_next) gemm_prefetch0(next, smem);
#pragma unroll
    for (int m = 0; m < NM; ++m) {
#pragma unroll
      for (int n = 0; n < 4; ++n) {
        const uint2 g = gt[m][n];
        yacc[m][n][0] += sigmoidf_(bflo(g.x)) * acc[m][n][0];
        yacc[m][n][1] += sigmoidf_(bfhi(g.x)) * acc[m][n][1];
        yacc[m][n][2] += sigmoidf_(bflo(g.y)) * acc[m][n][2];
        yacc[m][n][3] += sigmoidf_(bfhi(g.y)) * acc[m][n][3];
      }
    }
  }
  store_tile_lds<NM>(yacc, Y, 1024, brow, bcol, smem);
}

__device__ __forceinline__ GemmJob job_plain(const bf16_t* A, int lda, const bf16_t* Wt, int K, int brow, int pn, int nm) {
  GemmJob j; j.A = A; j.Bt = Wt; j.lda = lda; j.ldb = K; j.K = K; j.brow = brow; j.bcol = pn * 128; j.nm = nm; return j;
}
template <int ACT, int NM>
__device__ __forceinline__ void tile_plain(const bf16_t* A, int lda, const bf16_t* Wt, int K, bf16_t* O, int ldo, int brow, int pn, char* smem,
                                           const GemmJob next, const bool has_next) {
  const int tid = tidx(), wid = tid >> 6, lane = tid & 63, wr = wid >> 1, wc = wid & 1, fr = lane & 15, fq = lane >> 4;
  const int bcol = pn * 128, cs = bcol + wc * 64;
  f32x4 acc[NM][4];
  zero_acc<NM>(acc);
  gemm_run<NM>(job_plain(A, lda, Wt, K, brow, pn, NM), smem, acc);
  if (has_next) gemm_prefetch0(next, smem);
  if (ACT == 1) {
#pragma unroll
    for (int m = 0; m < NM; ++m)
#pragma unroll
      for (int n = 0; n < 4; ++n)
#pragma unroll
        for (int j = 0; j < 4; ++j) { const float r = fmaxf(acc[m][n][j], 0.f); acc[m][n][j] = r * r; }
  }
  store_tile_lds<NM>(acc, O, ldo, brow, bcol, smem);
}

template <int NCH>
__device__ __forceinline__ void load_tile64(const bf16_t* g, size_t ld, bf16_t* s, int LP, int tid) {
#pragma unroll
  for (int c0 = 0; c0 < 64 * NCH; c0 += 256) {
    const int c = c0 + tid, r = c / NCH, ch = c % NCH;
    const uint4 v = *(const uint4*)(g + (size_t)r * ld + ch * 8);
    *(uint4*)(s + r * LP + ch * 8) = v;
  }
}

template <int DQK, bool NA>
__device__ __forceinline__ void attn_tile(const bf16_t* Q, int ldq, const bf16_t* K1, int ldk1, const bf16_t* K2, int ldk2,
                                          const bf16_t* V, int ldv, bf16_t* O, int ldo, int nlin, int nloc, int loc_row0,
                                          float sl2, const float* rpb_h, int r_base, char* smem) {
  constexpr int NKS = DQK / 32, KBYTES = NKS * 4096, STG = KBYTES + 8192;
  const int tid = tidx(), wid = tid >> 6, lane = tid & 63, fr = lane & 15, fq = lane >> 4;
  float* rpb_s = (float*)(smem + 2 * STG);
  __syncthreads();
  if (NA) {
    for (int i = tid; i < 15 * 31; i += 256) rpb_s[i] = rpb_h[i] * LOG2E;
  }
  const int sr = tid >> 3, sch = tid & 7;
  const int sw_s = (0x78 >> (2 * ((sr >> 2) & 3))) & 3;
  const int k1_off = (sch >> 2) * 4096 + sr * 64 + (((sch & 3) ^ sw_s) << 4);
  const int v_off = KBYTES + sr * 128 + ((((sch >> 1) ^ ((sr >> 1) & 3))) << 5) + ((sch & 1) << 4);
  const int s2r = tid >> 2, s2p = tid & 3;
  const int sw_s2 = (0x78 >> (2 * ((s2r >> 2) & 3))) & 3;
  const int k2_off = 2 * 4096 + s2r * 64 + ((s2p ^ sw_s2) << 4);
  const bf16_t* gk1 = K1 + (size_t)sr * ldk1 + sch * 8;
  const bf16_t* gv = V + (size_t)sr * ldv + sch * 8;
  const bf16_t* gk2 = (DQK == 96) ? K2 + (size_t)s2r * ldk2 + s2p * 8 : nullptr;
  const int sw_r = (0x78 >> (2 * (fr >> 2))) & 3;
  const int koff = fr * 64 + ((fq ^ sw_r) << 4);
  const int xr = (2 * fq + (fr >> 3)) & 3;
  int voff[4];
#pragma unroll
  for (int db = 0; db < 4; ++db) voff[db] = KBYTES + (4 * fq + (fr >> 2)) * 128 + ((db ^ xr) << 5) + (fr & 3) * 8;

  bf16x8 qf[2][NKS];
#pragma unroll
  for (int q = 0; q < 2; ++q)
#pragma unroll
    for (int ks = 0; ks < NKS; ++ks) qf[q][ks] = *(const bf16x8*)(Q + (size_t)(wid * 32 + q * 16 + fr) * ldq + ks * 32 + fq * 8);
  f32x4 Oa[4][2];
#pragma unroll
  for (int db = 0; db < 4; ++db) { Oa[db][0] = (f32x4){0.f, 0.f, 0.f, 0.f}; Oa[db][1] = (f32x4){0.f, 0.f, 0.f, 0.f}; }
  float mrun[2] = {0.f, 0.f};
  f32x4 negm[2] = {(f32x4){0.f, 0.f, 0.f, 0.f}, (f32x4){0.f, 0.f, 0.f, 0.f}};
  f32x4 Osum[2] = {(f32x4){0.f, 0.f, 0.f, 0.f}, (f32x4){0.f, 0.f, 0.f, 0.f}};
  const bf16x8 ones = {16256, 16256, 16256, 16256, 16256, 16256, 16256, 16256};
  int qrow[2], qcol[2], r0q[2], c0q[2];
  if (NA) {
#pragma unroll
    for (int q = 0; q < 2; ++q) {
      const int qi = wid * 32 + q * 16 + fr;
      qrow[q] = r_base + (qi >> 6); qcol[q] = qi & 63;
      r0q[q] = min(max(qrow[q] - 4, 0), 120);
      c0q[q] = min(max(qcol[q] - 8, 0), 48);
    }
  }
  const int ntile = nlin + nloc;
  uint4 k1aRA, k1bRA, k2RA, vaRA, vbRA, k1aRB, k1bRB, k2RB, vaRB, vbRB;
#define ATT_LOAD(R, T)                                                                                \
  do {                                                                                                \
    const int t_ = (T);                                                                               \
    const size_t krow_ = (t_ < nlin) ? (size_t)t_ * 64 : (size_t)(CTX + (loc_row0 + (t_ - nlin)) * 64); \
    k1a##R = *(const uint4*)(gk1 + krow_ * ldk1);                                                      \
    k1b##R = *(const uint4*)(gk1 + (krow_ + 32) * ldk1);                                               \
    if (DQK == 96) k2##R = *(const uint4*)(gk2 + krow_ * ldk2);                                        \
    va##R = *(const uint4*)(gv + krow_ * ldv);                                                         \
    vb##R = *(const uint4*)(gv + (krow_ + 32) * ldv);                                                  \
  } while (0)
#define ATT_STORE(R, BUF)                                                                             \
  do {                                                                                                \
    char* st_ = smem + (BUF) * STG;                                                                   \
    *(uint4*)(st_ + k1_off) = k1a##R;                                                                  \
    *(uint4*)(st_ + k1_off + 2048) = k1b##R;                                                           \
    if (DQK == 96) *(uint4*)(st_ + k2_off) = k2##R;                                                    \
    *(uint4*)(st_ + v_off) = va##R;                                                                    \
    *(uint4*)(st_ + v_off + 4096) = vb##R;                                                             \
  } while (0)
  ATT_LOAD(RA, 0);
  ATT_STORE(RA, 0);
  if (ntile > 1) ATT_LOAD(RB, 1);
  __syncthreads();
#pragma unroll 1
  for (int t0 = 0; t0 < ntile; t0 += 2) {
#pragma unroll
  for (int par = 0; par < 2; ++par) {
    const int t = t0 + par;
    if (t < ntile) {
    const char* stg = smem + par * STG;
    if (t + 2 < ntile) { if (par == 0) ATT_LOAD(RA, t + 2); else ATT_LOAD(RB, t + 2); }
    f32x4 S[4][2];
    {
      bf16x8 kf[4][NKS];
#pragma unroll
      for (int kb = 0; kb < 4; ++kb)
#pragma unroll
        for (int ks = 0; ks < NKS; ++ks) kf[kb][ks] = *(const bf16x8*)(stg + ks * 4096 + kb * 1024 + koff);
      __builtin_amdgcn_sched_barrier(0);
#pragma unroll
      for (int kb = 0; kb < 4; ++kb) {
        S[kb][0] = negm[0]; S[kb][1] = negm[1];
#pragma unroll
        for (int ks = 0; ks < NKS; ++ks) {
          S[kb][0] = mfma16(kf[kb][ks], qf[0][ks], S[kb][0]);
          S[kb][1] = mfma16(kf[kb][ks], qf[1][ks], S[kb][1]);
        }
      }
      __builtin_amdgcn_sched_barrier(0);
    }
    const bool local = NA && (t >= nlin);
    const int kr = loc_row0 + (t - nlin);
    float mxq[2];
#pragma unroll
    for (int q = 0; q < 2; ++q) {
      if (NA) {
        if (local) {
          const bool rok = (kr >= r0q[q]) && (kr < r0q[q] + 8);
          const int u0 = fq * 4 - c0q[q];
          const float* bp = rpb_s + (kr - qrow[q] + 7) * 31 + (fq * 4 - qcol[q] + 15);
#pragma unroll
          for (int kb = 0; kb < 4; ++kb)
#pragma unroll
            for (int j = 0; j < 4; ++j) {
              const bool ok = rok && ((unsigned)(u0 + kb * 16 + j) < 16u);
              const float sb = S[kb][q][j] + bp[kb * 16 + j];
              S[kb][q][j] = ok ? sb : -1e30f;
            }
        }
      }
      float mx = fmax_nc(fmax_nc(S[0][q][0], S[0][q][1]), fmax_nc(S[0][q][2], S[0][q][3]));
#pragma unroll
      for (int kb = 1; kb < 4; ++kb) mx = fmax_nc(fmax_nc(mx, fmax_nc(S[kb][q][0], S[kb][q][1])), fmax_nc(S[kb][q][2], S[kb][q][3]));
      mx = xmax16(mx);
      mx = xmax32(mx);
      mxq[q] = mx;
    }
    const bool first = (t == 0);
    if (first || __any((mxq[0] > 8.f) || (mxq[1] > 8.f))) {
#pragma unroll
      for (int q = 0; q < 2; ++q) {
        const float d = (first || mxq[q] > 8.f) ? mxq[q] : 0.f;
        const float alpha = __builtin_amdgcn_exp2f(-d);
        mrun[q] += d;
        negm[q] = (f32x4){-mrun[q], -mrun[q], -mrun[q], -mrun[q]};
        Osum[q] = Osum[q] * alpha;
#pragma unroll
        for (int db = 0; db < 4; ++db) Oa[db][q] = Oa[db][q] * alpha;
#pragma unroll
        for (int kb = 0; kb < 4; ++kb) S[kb][q] = S[kb][q] - d;
      }
    }
#pragma unroll
    for (int q = 0; q < 2; ++q)
#pragma unroll
      for (int kb = 0; kb < 4; ++kb)
#pragma unroll
        for (int j = 0; j < 4; ++j) S[kb][q][j] = __builtin_amdgcn_exp2f(S[kb][q][j]);
#pragma unroll
    for (int ks2 = 0; ks2 < 2; ++ks2) {
      bf16x8 pf[2];
#pragma unroll
      for (int q = 0; q < 2; ++q) {
        union { bf16x8 v; unsigned u[4]; } cv;
        cv.u[0] = pack2(S[2 * ks2][q][0], S[2 * ks2][q][1]);
        cv.u[1] = pack2(S[2 * ks2][q][2], S[2 * ks2][q][3]);
        cv.u[2] = pack2(S[2 * ks2 + 1][q][0], S[2 * ks2 + 1][q][1]);
        cv.u[3] = pack2(S[2 * ks2 + 1][q][2], S[2 * ks2 + 1][q][3]);
        pf[q] = cv.v;
      }
      bf16x8 vf[4];
#pragma unroll
      for (int db = 0; db < 4; ++db) {
        const s16x4 v1 = tr_read((const bf16_t*)(stg + (2 * ks2) * 2048 + voff[db]));
        const s16x4 v2 = tr_read((const bf16_t*)(stg + (2 * ks2 + 1) * 2048 + voff[db]));
        vf[db] = (bf16x8){v1[0], v1[1], v1[2], v1[3], v2[0], v2[1], v2[2], v2[3]};
      }
      __builtin_amdgcn_sched_barrier(0);
      Osum[0] = mfma16(ones, pf[0], Osum[0]);
      Osum[1] = mfma16(ones, pf[1], Osum[1]);
#pragma unroll
      for (int db = 0; db < 4; ++db) {
        Oa[db][0] = mfma16(vf[db], pf[0], Oa[db][0]);
        Oa[db][1] = mfma16(vf[db], pf[1], Oa[db][1]);
      }
      __builtin_amdgcn_sched_barrier(0);
    }
    if (t + 1 < ntile) { if (par == 0) ATT_STORE(RB, 1); else ATT_STORE(RA, 0); }
    __syncthreads();
    }
  }
  }
#undef ATT_LOAD
#undef ATT_STORE
#pragma unroll
  for (int q = 0; q < 2; ++q) {
    const float inv = 1.f / Osum[q][0];
    bf16_t* orow = O + (size_t)(wid * 32 + q * 16 + fr) * ldo;
#pragma unroll
    for (int db = 0; db < 4; ++db) store4(orow + db * 16 + fq * 4, Oa[db][q] * inv);
  }
}

__device__ __forceinline__ void tile_mla(const Params& p, int idx, char* smem) {
  const int qt = idx % 66, bh = idx / 66, h = bh & 7, b = bh >> 3;
  const bf16_t* Qm = (const bf16_t*)(WS(p) + OFF_E);
  const bf16_t* KVm = (const bf16_t*)(WS(p) + OFF_E + SZ_QM);
  const bf16_t* P = (const bf16_t*)(WS(p) + OFF_P);
  bf16_t* yc = (bf16_t*)(WS(p) + OFF_YC);
  const bool isx = qt < 64;
  const int qrow0 = b * TB + (isx ? CTX + qt * 128 : (qt - 64) * 128);
  const size_t brow = (size_t)b * TB;
  attn_tile<96, false>(Qm + (size_t)qrow0 * 768 + h * 96, 768, KVm + brow * 1024 + h * 128, 1024, P + brow * NP + C_KR, NP,
                       KVm + brow * 1024 + h * 128 + 64, 1024, yc + (size_t)qrow0 * 512 + h * 64, 512, isx ? TB / 64 : CTX / 64, 0, 0,
                       0.10206207261596575f * LOG2E, nullptr, 0, smem);
}
__device__ __forceinline__ void tile_na(const Params& p, int l, int idx, char* smem) {
  const int qt = idx % 66, bh = idx / 66, h = bh & 7, b = bh >> 3;
  const bf16_t* P = (const bf16_t*)(WS(p) + OFF_P);
  bf16_t* yb = (bf16_t*)(WS(p) + OFF_D + SZ_YC);
  const bool isx = qt < 64;
  const int qrow0 = b * TB + (isx ? CTX + qt * 128 : (qt - 64) * 128);
  const size_t brow = (size_t)b * TB;
  int nloc = 0, rlo = 0;
  if (isx) {
    const int r = 2 * qt;
    rlo = min(max(r - 4, 0), 120);
    const int rhi = min(max(r + 1 - 4, 0), 120) + 7;
    nloc = rhi - rlo + 1;
  }
  attn_tile<64, true>(P + (size_t)qrow0 * NP + C_NQ + h * 64, NP, P + brow * NP + C_NK + h * 64, NP, nullptr, 0,
                      P + brow * NP + C_NV + h * 64, NP, yb + (size_t)qrow0 * 512 + h * 64, 512, CTX / 64, nloc, rlo, 0.125f * LOG2E,
                      p.na_rpb + ((size_t)l * 8 + h) * 15 * 31, 2 * qt, smem);
}

__device__ __forceinline__ float ret_lg2(const Params& p, int l, int dir, int h) {
  const float ld = p.ret_log_decay[(l * 2 + dir) * 4 + h];
  return log1pf(-expf(ld)) * LOG2E;
}
__device__ __forceinline__ void tile_retkv(const Params& p, int l, int idx, char* smem) {
  const int tid = tidx(), wid = tid >> 6, lane = tid & 63, fr = lane & 15, fq = lane >> 4;
  const int c = idx % NCHUNK, bh = idx / NCHUNK, h = bh & 3, b = bh >> 2;
  const bf16_t* P = (const bf16_t*)(WS(p) + OFF_P);
  float* ST = (float*)(WS(p) + OFF_ST);
  const size_t row0 = (size_t)b * TB + c * 128;
  const float lgf = ret_lg2(p, l, 0, h), lgb = ret_lg2(p, l, 1, h);
  constexpr int KP = 72, VP = 136;
  bf16_t* Kf = (bf16_t*)smem;
  bf16_t* Kb = Kf + 64 * KP;
  bf16_t* Vs = Kb + 64 * KP;
  f32x4 acc[2][4][2];
#pragma unroll
  for (int d = 0; d < 2; ++d)
#pragma unroll
    for (int a = 0; a < 4; ++a) { acc[d][a][0] = (f32x4){0.f, 0.f, 0.f, 0.f}; acc[d][a][1] = (f32x4){0.f, 0.f, 0.f, 0.f}; }
#pragma unroll 1
  for (int sh = 0; sh < 2; ++sh) {
    __syncthreads();
#pragma unroll
    for (int c0 = 0; c0 < 512; c0 += 256) {
      const int cc = c0 + tid, r = cc >> 3, ch = cc & 7;
      const int s = sh * 64 + r;
      const uint4 v = *(const uint4*)(P + (row0 + s) * NP + C_RK + h * 64 + ch * 8);
      const float df = __builtin_amdgcn_exp2f(lgf * (float)(127 - s)), db = __builtin_amdgcn_exp2f(lgb * (float)s);
      uint4 wf, wb;
      wf.x = pack2(bflo(v.x) * df, bfhi(v.x) * df); wb.x = pack2(bflo(v.x) * db, bfhi(v.x) * db);
      wf.y = pack2(bflo(v.y) * df, bfhi(v.y) * df); wb.y = pack2(bflo(v.y) * db, bfhi(v.y) * db);
      wf.z = pack2(bflo(v.z) * df, bfhi(v.z) * df); wb.z = pack2(bflo(v.z) * db, bfhi(v.z) * db);
      wf.w = pack2(bflo(v.w) * df, bfhi(v.w) * df); wb.w = pack2(bflo(v.w) * db, bfhi(v.w) * db);
      *(uint4*)(Kf + r * KP + ch * 8) = wf;
      *(uint4*)(Kb + r * KP + ch * 8) = wb;
    }
    load_tile64<16>(P + (row0 + sh * 64) * NP + C_RV + h * 128, NP, Vs, VP, tid);
    __syncthreads();
#pragma unroll
    for (int ks = 0; ks < 2; ++ks) {
      const int ra = (ks * 32 + 4 * fq + (fr >> 2)), rb = ra + 16, co = 4 * (fr & 3);
      bf16x8 vf[2];
#pragma unroll
      for (int dvb = 0; dvb < 2; ++dvb) {
        const s16x4 v1 = tr_read(Vs + ra * VP + (wid * 2 + dvb) * 16 + co);
        const s16x4 v2 = tr_read(Vs + rb * VP + (wid * 2 + dvb) * 16 + co);
        vf[dvb] = (bf16x8){v1[0], v1[1], v1[2], v1[3], v2[0], v2[1], v2[2], v2[3]};
      }
#pragma unroll
      for (int dkb = 0; dkb < 4; ++dkb) {
        const s16x4 a1 = tr_read(Kf + ra * KP + dkb * 16 + co);
        const s16x4 a2 = tr_read(Kf + rb * KP + dkb * 16 + co);
        const bf16x8 kff = {a1[0], a1[1], a1[2], a1[3], a2[0], a2[1], a2[2], a2[3]};
        const s16x4 b1 = tr_read(Kb + ra * KP + dkb * 16 + co);
        const s16x4 b2 = tr_read(Kb + rb * KP + dkb * 16 + co);
        const bf16x8 kfb = {b1[0], b1[1], b1[2], b1[3], b2[0], b2[1], b2[2], b2[3]};
#pragma unroll
        for (int dvb = 0; dvb < 2; ++dvb) {
          acc[0][dkb][dvb] = mfma16(kff, vf[dvb], acc[0][dkb][dvb]);
          acc[1][dkb][dvb] = mfma16(kfb, vf[dvb], acc[1][dkb][dvb]);
        }
      }
    }
  }
#pragma unroll
  for (int d = 0; d < 2; ++d) {
    float* dst = ST + ((size_t)((d * 2 + b) * 4 + h) * NCHUNK + c) * 8192;
#pragma unroll
    for (int dkb = 0; dkb < 4; ++dkb)
#pragma unroll
      for (int dvb = 0; dvb < 2; ++dvb)
#pragma unroll
        for (int j = 0; j < 4; ++j) dst[(dkb * 16 + 4 * fq + j) * 128 + (wid * 2 + dvb) * 16 + fr] = acc[d][dkb][dvb][j];
  }
}
__device__ __forceinline__ void unit_scan(const Params& p, int l, int u) {
  const int e = u * 256 + tidx();
  const int i = e & 8191, h = (e >> 13) & 3, b = (e >> 15) & 1, dir = e >> 16;
  float* base = (float*)(WS(p) + OFF_ST) + (size_t)((dir * 2 + b) * 4 + h) * NCHUNK * 8192 + i;
  const float cd = exp2f(ret_lg2(p, l, dir, h) * 128.f);
  float s = 0.f;
#pragma unroll 1
  for (int k0 = 0; k0 < NCHUNK; k0 += 11) {
    float tmp[11];
#pragma unroll
    for (int k = 0; k < 11; ++k) {
      const int kk = k0 + k;
      const int c = dir == 0 ? kk : (kk < 2 ? 1 - kk : NCHUNK + 1 - kk);
      tmp[k] = base[(size_t)c * 8192];
    }
#pragma unroll
    for (int k = 0; k < 11; ++k) {
      const int kk = k0 + k;
      const int c = dir == 0 ? kk : (kk < 2 ? 1 - kk : NCHUNK + 1 - kk);
      base[(size_t)c * 8192] = s;
      s = s * cd + tmp[k];
    }
  }
}
__device__ __forceinline__ void tile_retout(const Params& p, int l, int idx, char* smem) {
  const int tid = tidx(), wid = tid >> 6, lane = tid & 63, fr = lane & 15, fq = lane >> 4;
  const int qh = idx & 1, cidx = idx >> 1, c = cidx % NCHUNK, bh = cidx / NCHUNK, h = bh & 3, b = bh >> 2;
  const bf16_t* P = (const bf16_t*)(WS(p) + OFF_P);
  const float* ST = (const float*)(WS(p) + OFF_ST);
  bf16_t* ya = (bf16_t*)(WS(p) + OFF_D);
  const size_t row0 = (size_t)b * TB + c * 128;
  constexpr int KP = 72, VP = 136;
  bf16_t* Ks = (bf16_t*)smem;
  bf16_t* Vs = Ks + 64 * KP;
  bf16_t* Ss = Vs + 64 * VP;
  const int n = qh * 64 + wid * 16 + fr;
  const size_t qrow = row0 + n;
  const bf16_t* qp = P + qrow * NP + C_RQ + h * 64;
  bf16x8 qf[2];
  qf[0] = *(const bf16x8*)(qp + fq * 8);
  qf[1] = *(const bf16x8*)(qp + 32 + fq * 8);
  float qx[2][8];
#pragma unroll
  for (int ks = 0; ks < 2; ++ks) {
    const uint2 a = *(const uint2*)(qp + ks * 32 + 4 * fq);
    const uint2 bq = *(const uint2*)(qp + ks * 32 + 16 + 4 * fq);
    qx[ks][0] = bflo(a.x); qx[ks][1] = bfhi(a.x); qx[ks][2] = bflo(a.y); qx[ks][3] = bfhi(a.y);
    qx[ks][4] = bflo(bq.x); qx[ks][5] = bfhi(bq.x); qx[ks][6] = bflo(bq.y); qx[ks][7] = bfhi(bq.y);
  }
  bf16_t* yp = ya + qrow * 512 + h * 128;
  const float lg01[2] = {ret_lg2(p, l, 0, h), ret_lg2(p, l, 1, h)};
  uint4 pre[8];
  f32x4 Oa[8];
#define RO_ISX(i) (qh == 0 ? ((i) == 1 || (i) == 4) : ((i) == 2 || (i) == 4))
#define RO_DIR(i) (qh == 0 ? ((i) >= 2 ? 1 : 0) : ((i) >= 3 ? 1 : 0))
#define RO_KH(i) (qh == 0 ? ((i) == 3 ? 1 : 0) : ((i) == 0 ? 0 : 1))
#define RO_ISSUE(i)                                                                                                 \
  do {                                                                                                              \
    const int i_ = (i);                                                                                             \
    if (RO_ISX(i_)) {                                                                                               \
      const float* sp_ = ST + ((size_t)((RO_DIR(i_) * 2 + b) * 4 + h) * NCHUNK + c) * 8192;                         \
      _Pragma("unroll") for (int j_ = 0; j_ < 8; ++j_) pre[j_] = *(const uint4*)(sp_ + (j_ * 256 + tid) * 4);       \
    } else {                                                                                                        \
      const size_t kr_ = row0 + RO_KH(i_) * 64;                                                                     \
      _Pragma("unroll") for (int j_ = 0; j_ < 2; ++j_) {                                                            \
        const int cc_ = j_ * 256 + tid;                                                                             \
        pre[j_] = *(const uint4*)(P + (kr_ + (cc_ >> 3)) * NP + C_RK + h * 64 + (cc_ & 7) * 8);                     \
      }                                                                                                             \
      _Pragma("unroll") for (int j_ = 0; j_ < 4; ++j_) {                                                            \
        const int cc_ = j_ * 256 + tid;                                                                             \
        pre[2 + j_] = *(const uint4*)(P + (kr_ + (cc_ >> 4)) * NP + C_RV + h * 128 + (cc_ & 15) * 8);               \
      }                                                                                                             \
    }                                                                                                               \
  } while (0)
  RO_ISSUE(0);
#pragma unroll 1
  for (int i = 0; i < 5; ++i) {
    const bool isx = RO_ISX(i);
    const int dir = RO_DIR(i), kh = RO_KH(i);
    const float lg = lg01[dir];
    __syncthreads();
    if (isx) {
#pragma unroll
      for (int j = 0; j < 8; ++j) {
        const int cc = j * 256 + tid, r = cc >> 5, ch = cc & 31;
        uint2 w;
        w.x = pack2(__uint_as_float(pre[j].x), __uint_as_float(pre[j].y));
        w.y = pack2(__uint_as_float(pre[j].z), __uint_as_float(pre[j].w));
        *(uint2*)(Ss + r * VP + ch * 4) = w;
      }
    } else {
#pragma unroll
      for (int j = 0; j < 2; ++j) { const int cc = j * 256 + tid; *(uint4*)(Ks + (cc >> 3) * KP + (cc & 7) * 8) = pre[j]; }
#pragma unroll
      for (int j = 0; j < 4; ++j) { const int cc = j * 256 + tid; *(uint4*)(Vs + (cc >> 4) * VP + (cc & 15) * 8) = pre[2 + j]; }
    }
    if (i + 1 < 5) RO_ISSUE(i + 1);
    __syncthreads();
    if (i == 0 || i == (qh == 0 ? 2 : 3)) {
#pragma unroll
      for (int db = 0; db < 8; ++db) Oa[db] = (f32x4){0.f, 0.f, 0.f, 0.f};
    }
    if (!isx) {
      f32x4 S[4];
#pragma unroll
      for (int kb = 0; kb < 4; ++kb) {
        S[kb] = (f32x4){0.f, 0.f, 0.f, 0.f};
#pragma unroll
        for (int ks = 0; ks < 2; ++ks) {
          const bf16x8 kf = *(const bf16x8*)(Ks + (kb * 16 + fr) * KP + ks * 32 + fq * 8);
          S[kb] = mfma16(kf, qf[ks], S[kb]);
        }
#pragma unroll
        for (int j = 0; j < 4; ++j) {
          const int m = kh * 64 + kb * 16 + 4 * fq + j;
          const int dd = dir == 0 ? (n - m) : (m - n);
          const float w = dd >= 0 ? __builtin_amdgcn_exp2f(lg * (float)dd) : 0.f;
          S[kb][j] *= w;
        }
      }
#pragma unroll
      for (int ks2 = 0; ks2 < 2; ++ks2) {
        union { bf16x8 v; unsigned u[4]; } cv;
        cv.u[0] = pack2(S[2 * ks2][0], S[2 * ks2][1]);
        cv.u[1] = pack2(S[2 * ks2][2], S[2 * ks2][3]);
        cv.u[2] = pack2(S[2 * ks2 + 1][0], S[2 * ks2 + 1][1]);
        cv.u[3] = pack2(S[2 * ks2 + 1][2], S[2 * ks2 + 1][3]);
#pragma unroll
        for (int db = 0; db < 8; ++db) {
          const s16x4 v1 = tr_read(Vs + ((2 * ks2) * 16 + 4 * fq + (fr >> 2)) * VP + db * 16 + 4 * (fr & 3));
          const s16x4 v2 = tr_read(Vs + ((2 * ks2 + 1) * 16 + 4 * fq + (fr >> 2)) * VP + db * 16 + 4 * (fr & 3));
          const bf16x8 vf = {v1[0], v1[1], v1[2], v1[3], v2[0], v2[1], v2[2], v2[3]};
          Oa[db] = mfma16(vf, cv.v, Oa[db]);
        }
      }
    } else {
      const float qd = __builtin_amdgcn_exp2f(lg * (float)(dir == 0 ? (n + 1) : (128 - n)));
#pragma unroll
      for (int ks = 0; ks < 2; ++ks) {
        union { bf16x8 v; unsigned u[4]; } cv;
        cv.u[0] = pack2(qx[ks][0] * qd, qx[ks][1] * qd);
        cv.u[1] = pack2(qx[ks][2] * qd, qx[ks][3] * qd);
        cv.u[2] = pack2(qx[ks][4] * qd, qx[ks][5] * qd);
        cv.u[3] = pack2(qx[ks][6] * qd, qx[ks][7] * qd);
#pragma unroll
        for (int db = 0; db < 8; ++db) {
          const s16x4 v1 = tr_read(Ss + (ks * 32 + 4 * fq + (fr >> 2)) * VP + db * 16 + 4 * (fr & 3));
          const s16x4 v2 = tr_read(Ss + (ks * 32 + 16 + 4 * fq + (fr >> 2)) * VP + db * 16 + 4 * (fr & 3));
          const bf16x8 sf = {v1[0], v1[1], v1[2], v1[3], v2[0], v2[1], v2[2], v2[3]};
          Oa[db] = mfma16(sf, cv.v, Oa[db]);
        }
      }
      float sm = 0.f;
#pragma unroll
      for (int db = 0; db < 8; ++db) sm += (Oa[db][0] + Oa[db][1]) + (Oa[db][2] + Oa[db][3]);
      sm = xadd32(xadd16(sm));
      const float mean = sm * (1.f / 128.f);
      float vq = 0.f;
#pragma unroll
      for (int db = 0; db < 8; ++db)
#pragma unroll
        for (int j = 0; j < 4; ++j) { const float dlt = Oa[db][j] - mean; vq += dlt * dlt; }
      vq = xadd32(xadd16(vq));
      const float rstd = rsqrtf(vq * (1.f / 128.f) + EPS);
      const bf16_t* gp = P + qrow * NP + (dir == 0 ? C_GF : C_GB) + h * 128;
      const float* gn = p.ret_gn_gain + l * 512 + h * 128;
#pragma unroll
      for (int db = 0; db < 8; ++db) {
        const uint2 g = *(const uint2*)(gp + db * 16 + 4 * fq);
        const float4 gg = *(const float4*)(gn + db * 16 + 4 * fq);
        const float g0 = bflo(g.x), g1 = bfhi(g.x), g2 = bflo(g.y), g3 = bfhi(g.y);
        f32x4 y;
        y[0] = g0 * sigmoidf_(g0) * ((Oa[db][0] - mean) * rstd * gg.x);
        y[1] = g1 * sigmoidf_(g1) * ((Oa[db][1] - mean) * rstd * gg.y);
        y[2] = g2 * sigmoidf_(g2) * ((Oa[db][2] - mean) * rstd * gg.z);
        y[3] = g3 * sigmoidf_(g3) * ((Oa[db][3] - mean) * rstd * gg.w);
        if (dir == 1) {
          const uint2 pv = *(const uint2*)(yp + db * 16 + 4 * fq);
          y[0] += bflo(pv.x); y[1] += bfhi(pv.x); y[2] += bflo(pv.y); y[3] += bfhi(pv.y);
        }
        store4(yp + db * 16 + 4 * fq, y);
      }
    }
  }
#undef RO_ISX
#undef RO_DIR
#undef RO_KH
#undef RO_ISSUE
}

__device__ __forceinline__ void rows_phase(const Params& p, bool from_input, const bf16_t* add, int g_l, int g_chunk, const float* ln_g,
                                           const float* ln_b, int h_l, int sh_chunk, bf16_t* H) {
  const int wid = tidx() >> 6, lane = tidx() & 63;
  const float* MOD = (const float*)(WS(p) + OFF_MOD);
  const int stride = gridDim.x * 8;
  float4 xv[2][4];
  uint2 av[2][4];
#define ROWS_FETCH(R0)                                                                                                    \
  do {                                                                                                                    \
    _Pragma("unroll") for (int r_ = 0; r_ < 2; ++r_) {                                                                    \
      const int row_ = (R0) + r_;                                                                                         \
      const int b_ = row_ / TB, t_ = row_ - b_ * TB;                                                                      \
      const float* src_ = from_input ? (t_ < CTX ? p.ctx + (size_t)(b_ * CTX + t_) * D : p.x + ((size_t)b_ * SEQ + (t_ - CTX)) * D) \
                                     : xrow_ptr(p, row_);                                                                 \
      _Pragma("unroll") for (int i_ = 0; i_ < 4; ++i_) {                                                                  \
        xv[r_][i_] = *(const float4*)(src_ + i_ * 256 + lane * 4);                                                        \
        if (!from_input) av[r_][i_] = *(const uint2*)(add + (size_t)row_ * 1024 + i_ * 256 + lane * 4);                   \
      }                                                                                                                   \
    }                                                                                                                     \
  } while (0)
  float4 lng[4], lnb[4];
  if (!from_input) {
#pragma unroll
    for (int i = 0; i < 4; ++i) { lng[i] = *(const float4*)(ln_g + i * 256 + lane * 4); lnb[i] = *(const float4*)(ln_b + i * 256 + lane * 4); }
  }
  int row0 = (blockIdx.x * 4 + wid) * 2;
  if (row0 < MROWS) ROWS_FETCH(row0);
  for (; row0 < MROWS; row0 += stride) {
    float4 v[2][4];
    int mv[2];
    float* xr[2];
#pragma unroll
    for (int r = 0; r < 2; ++r) {
      const int row = row0 + r;
      const int b = row / TB, t = row - b * TB;
      mv[r] = t < CTX ? 2 : b;
      xr[r] = xrow_ptr(p, row);
      if (from_input) {
#pragma unroll
        for (int i = 0; i < 4; ++i) v[r][i] = xv[r][i];
      } else {
        const float* gm = MOD + (size_t)(g_l * 3 + mv[r]) * 6144 + g_chunk * 1024;
#pragma unroll
        for (int i = 0; i < 4; ++i) {
          const float4 gv = *(const float4*)(gm + i * 256 + lane * 4);
          v[r][i].x = ALPHA * xv[r][i].x + gv.x * bflo(av[r][i].x);
          v[r][i].y = ALPHA * xv[r][i].y + gv.y * bfhi(av[r][i].x);
          v[r][i].z = ALPHA * xv[r][i].z + gv.z * bflo(av[r][i].y);
          v[r][i].w = ALPHA * xv[r][i].w + gv.w * bfhi(av[r][i].y);
        }
      }
    }
    float4 shv[4], scv[4];
    if (H) {
      const float* mm = MOD + (size_t)(h_l * 3 + mv[0]) * 6144;
#pragma unroll
      for (int i = 0; i < 4; ++i) {
        shv[i] = *(const float4*)(mm + sh_chunk * 1024 + i * 256 + lane * 4);
        scv[i] = *(const float4*)(mm + (sh_chunk + 1) * 1024 + i * 256 + lane * 4);
      }
    }
    if (row0 + stride < MROWS) ROWS_FETCH(row0 + stride);
    if (!from_input) {
      float s[2], q[2];
#pragma unroll
      for (int r = 0; r < 2; ++r) {
        s[r] = 0.f;
#pragma unroll
        for (int i = 0; i < 4; ++i) s[r] += (v[r][i].x + v[r][i].y) + (v[r][i].z + v[r][i].w);
      }
      s[0] = wave_sum(s[0]); s[1] = wave_sum(s[1]);
#pragma unroll
      for (int r = 0; r < 2; ++r) {
        const float mean = s[r] * (1.f / 1024.f);
        s[r] = mean;
        q[r] = 0.f;
#pragma unroll
        for (int i = 0; i < 4; ++i) {
          const float a0 = v[r][i].x - mean, a1 = v[r][i].y - mean, a2 = v[r][i].z - mean, a3 = v[r][i].w - mean;
          q[r] += (a0 * a0 + a1 * a1) + (a2 * a2 + a3 * a3);
        }
      }
      q[0] = wave_sum(q[0]); q[1] = wave_sum(q[1]);
#pragma unroll
      for (int i = 0; i < 4; ++i) {
        const float4 gg = lng[i], bb = lnb[i];
#pragma unroll
        for (int r = 0; r < 2; ++r) {
          const float mean = s[r], rstd = rsqrtf(q[r] * (1.f / 1024.f) + EPS);
          v[r][i].x = (v[r][i].x - mean) * rstd * gg.x + bb.x;
          v[r][i].y = (v[r][i].y - mean) * rstd * gg.y + bb.y;
          v[r][i].z = (v[r][i].z - mean) * rstd * gg.z + bb.z;
          v[r][i].w = (v[r][i].w - mean) * rstd * gg.w + bb.w;
        }
      }
    }
#pragma unroll
    for (int r = 0; r < 2; ++r) {
#pragma unroll
      for (int i = 0; i < 4; ++i) *(float4*)(xr[r] + i * 256 + lane * 4) = v[r][i];
      if (H) {
#pragma unroll
        for (int i = 0; i < 4; ++i) {
          const float4 sh = shv[i], sc = scv[i];
          uint2 w;
          w.x = pack2(v[r][i].x * (1.f + sc.x) + sh.x, v[r][i].y * (1.f + sc.y) + sh.y);
          w.y = pack2(v[r][i].z * (1.f + sc.z) + sh.z, v[r][i].w * (1.f + sc.w) + sh.w);
          *(uint2*)(H + (size_t)(row0 + r) * 1024 + i * 256 + lane * 4) = w;
        }
      }
    }
  }
#undef ROWS_FETCH
}

__device__ __forceinline__ void convert_mat(const float* W, int K, int N, bf16_t* Wt, int perm, const float* rs, char* smem) {
  float* tile = (float*)smem;
  const int tid = tidx(), tx = tid & 31, ty = tid >> 5;
  const int nkt = K / 64, nnt = N / 32, ntile = nkt * nnt;
  for (int ti = blockIdx.x; ti < ntile; ti += gridDim.x) {
    const int nt = ti % nnt, kt = ti / nnt;
    const int n0 = nt * 32, k0 = kt * 64;
    __syncthreads();
#pragma unroll
    for (int i = 0; i < 2; ++i) {
      const int kr = (tid >> 3) + 32 * i, k = k0 + kr, c4 = (tid & 7) * 4;
      float4 v = *(const float4*)(W + (size_t)k * N + n0 + c4);
      if (rs) { const float g = rs[k]; v.x *= g; v.y *= g; v.z *= g; v.w *= g; }
      float* tp = tile + kr * 33 + c4;
      tp[0] = v.x; tp[1] = v.y; tp[2] = v.z; tp[3] = v.w;
    }
    __syncthreads();
    int d0 = n0;
    if (perm == 1) d0 = (n0 < 4096) ? n0 : (n0 < 4128 ? C_KR + (n0 - 4096) : n0 - 32);
#pragma unroll
    for (int i = 0; i < 4; ++i) {
      const int nn = ty + 8 * i;
      *(unsigned*)(Wt + (size_t)(d0 + nn) * K + k0 + 2 * tx) = pack2(tile[(2 * tx) * 33 + nn], tile[(2 * tx + 1) * 33 + nn]);
    }
  }
}


__device__ __forceinline__ void convert_layer(const Params& p, int l, char* smem) {
  const int G = gridDim.x, bid = blockIdx.x;
  char* wt = WS(p) + OFF_WT;
  convert_mat(p.w_in + (size_t)l * 1024 * INW, 1024, INW, (bf16_t*)(wt + WT_IN), 1, nullptr, smem);
  {
    uint4* z = (uint4*)(wt + WT_IN + (size_t)INW * 1024 * 2);
    const uint4 zz = {0u, 0u, 0u, 0u};
    for (int i = bid * 256 + tidx(); i < (NP - INW) * 1024 * 2 / 16; i += G * 256) z[i] = zz;
  }
  convert_mat(p.mla_w_qup + (size_t)l * 256 * 768, 256, 768, (bf16_t*)(wt + WT_QUP), 0, p.mla_q_norm + l * 256, smem);
  convert_mat(p.mla_w_kvup + (size_t)l * 256 * 1024, 256, 1024, (bf16_t*)(wt + WT_KVUP), 0, p.mla_kv_norm + l * 256, smem);
  convert_mat(p.w_br_ret + (size_t)l * 512 * 1024, 512, 1024, (bf16_t*)(wt + WT_BR), 0, nullptr, smem);
  convert_mat(p.w_br_na + (size_t)l * 512 * 1024, 512, 1024, (bf16_t*)(wt + WT_BR + (size_t)1024 * 512 * 2), 0, nullptr, smem);
  convert_mat(p.w_br_mla + (size_t)l * 512 * 1024, 512, 1024, (bf16_t*)(wt + WT_BR + (size_t)2 * 1024 * 512 * 2), 0, nullptr, smem);
  convert_mat(p.w_out + (size_t)l * 1024 * 1024, 1024, 1024, (bf16_t*)(wt + WT_OUT), 0, nullptr, smem);
  convert_mat(p.w_ff1 + (size_t)l * 1024 * 4096, 1024, 4096, (bf16_t*)(wt + WT_FF1), 0, nullptr, smem);
  convert_mat(p.w_ff2 + (size_t)l * 4096 * 1024, 4096, 1024, (bf16_t*)(wt + WT_FF2), 0, nullptr, smem);
}

__device__ __forceinline__ void phase_init(const Params& p, char* smem) {
  const int tid = tidx();
  {
    float* T64c = (float*)(WS(p) + OFF_TAB);
    float* T64s = T64c + 128 * 16;
    float* T32c = T64s + 128 * 16;
    float* T32s = T32c + 128 * 8;
    for (int i = blockIdx.x * 256 + tid; i < 128 * 16 + 128 * 8; i += gridDim.x * 256) {
      if (i < 128 * 16) {
        const int pp = i >> 4, f = i & 15;
        const float inv = powf(10000.f, -(float)f / 16.f);
        const float ang = (float)pp * inv;
        T64c[i] = cosf(ang); T64s[i] = sinf(ang);
      } else {
        const int k = i - 128 * 16, pp = k >> 3, f = k & 7;
        const float inv = powf(10000.f, -(float)f / 8.f);
        const float ang = (float)pp * inv;
        T32c[k] = cosf(ang); T32s[k] = sinf(ang);
      }
    }
  }
  float* sc = (float*)smem;
  float* red = sc + 3 * 1024;
  for (int i = tid; i < 3 * 1024; i += 256) {
    const int v = i >> 10, k = i & 1023;
    const float cv = v < 2 ? p.c[v * 1024 + k] : p.c_ctx[k];
    sc[i] = cv / (1.f + __expf(-cv));
  }
  __syncthreads();
  float* MOD = (float*)(WS(p) + OFF_MOD);
  const int c4 = tid & 7, kg = tid >> 3;
  for (int u = blockIdx.x; u < DEPTH * 192; u += gridDim.x) {
    const int l = u / 192, n0 = (u % 192) * 32;
    const float* W = p.w_ada + (size_t)l * 1024 * 6144 + n0 + c4 * 4;
    float4 a0 = {0.f, 0.f, 0.f, 0.f}, a1 = a0, a2 = a0;
#pragma unroll 16
    for (int k = kg * 32; k < kg * 32 + 32; ++k) {
      const float4 w = *(const float4*)(W + (size_t)k * 6144);
      const float s0 = sc[k], s1 = sc[1024 + k], s2 = sc[2048 + k];
      a0.x += s0 * w.x; a0.y += s0 * w.y; a0.z += s0 * w.z; a0.w += s0 * w.w;
      a1.x += s1 * w.x; a1.y += s1 * w.y; a1.z += s1 * w.z; a1.w += s1 * w.w;
      a2.x += s2 * w.x; a2.y += s2 * w.y; a2.z += s2 * w.z; a2.w += s2 * w.w;
    }
    __syncthreads();
    *(float4*)(red + (kg * 3 + 0) * 32 + c4 * 4) = a0;
    *(float4*)(red + (kg * 3 + 1) * 32 + c4 * 4) = a1;
    *(float4*)(red + (kg * 3 + 2) * 32 + c4 * 4) = a2;
    __syncthreads();
    if (tid < 96) {
      const int v = tid >> 5, cc = tid & 31;
      float s = p.b_ada[l * 6144 + n0 + cc];
#pragma unroll
      for (int g = 0; g < 32; ++g) s += red[(g * 3 + v) * 32 + cc];
      MOD[(size_t)(l * 3 + v) * 6144 + n0 + cc] = s;
    }
  }
}


#define XB_TMO      128
#define XB_XCNT(j)  (256  + 64 * (j))
#define XB_XSUB(j)  (1280 + 64 * (j))
#define XB_XGEN(j)  (2304 + 64 * (j))
#define XB_TOP      3328
#define XB_TOPGEN   3392
#define XCD_BAR_WORDS 3456
#define XB_SPIN_CAP (1u << 20)
__device__ __forceinline__ unsigned xb_ld(unsigned* p) { return __hip_atomic_load(p, __ATOMIC_RELAXED, __HIP_MEMORY_SCOPE_AGENT); }
__device__ __forceinline__ unsigned xb_add(unsigned* p, unsigned v) { return __hip_atomic_fetch_add(p, v, __ATOMIC_RELAXED, __HIP_MEMORY_SCOPE_AGENT); }
__device__ __forceinline__ unsigned xb_xcc_id() { return (unsigned)__builtin_amdgcn_s_getreg((3 << 11) | 20) & 0xFu; }
#define XB_SPIN(cond, bar) do { unsigned _sp = 0; while (cond) { __builtin_amdgcn_s_sleep(1); \
    if ((++_sp & 255u) == 0u) { if (xb_ld(&(bar)[XB_TMO])) break; if (_sp > XB_SPIN_CAP) { atomicAdd(&(bar)[XB_TMO], 1u); break; } } } } while (0)
struct XcdBarrier { unsigned* bar; unsigned x; volatile AS3 unsigned* st; };
__device__ __forceinline__ XcdBarrier xcd_barrier_post(unsigned* bar, volatile AS3 unsigned* st) {
  XcdBarrier b; b.bar = bar; b.x = xb_xcc_id(); b.st = st;
  if (threadIdx.x == 0) (void)xb_add(&bar[XB_XCNT(b.x)], 1u);
  return b;
}
__device__ __forceinline__ void xcd_barrier_complete(unsigned* bar, unsigned x, unsigned& nloc, unsigned& nx) {
  const unsigned G = gridDim.x * gridDim.y * gridDim.z;
  unsigned sum, cnt, mine, sp = 0u;
  for (;;) {
    sum = 0u; cnt = 0u; mine = 0u;
#pragma unroll
    for (unsigned j = 0; j < 16; ++j) { const unsigned c = xb_ld(&bar[XB_XCNT(j)]); sum += c; cnt += (c > 0u) ? 1u : 0u; mine = (j == x) ? c : mine; }
    if (sum == G) break;
    __builtin_amdgcn_s_sleep(1);
    if ((++sp & 255u) == 0u) { if (xb_ld(&bar[XB_TMO])) break; if (sp > XB_SPIN_CAP) { atomicAdd(&bar[XB_TMO], 1u); break; } }
  }
  nloc = mine > 0u ? mine : 1u; nx = cnt > 0u ? cnt : 1u;
}
__device__ __forceinline__ void xcd_barrier(const XcdBarrier& b) {
  asm volatile("s_waitcnt vmcnt(0)" ::: "memory");
  __syncthreads();
  if (threadIdx.x == 0) {
    unsigned* bar = b.bar;
    __builtin_amdgcn_s_waitcnt(0);
    unsigned nloc = b.st[0], nx = b.st[1];
    if (nloc == 0u) { xcd_barrier_complete(bar, b.x, nloc, nx); b.st[0] = nloc; b.st[1] = nx; }
    const unsigned old = xb_add(&bar[XB_XSUB(b.x)], 1u);
    const unsigned gen = old / nloc;
    if (old + 1u == (gen + 1u) * nloc) {
      __builtin_amdgcn_fence(__ATOMIC_RELEASE, "agent");
      asm volatile("s_waitcnt vmcnt(0)" ::: "memory");
      const unsigned og = xb_add(&bar[XB_TOP], 1u);
      const unsigned tg = og / nx;
      if (og + 1u == (tg + 1u) * nx) xb_add(&bar[XB_TOPGEN], 1u);
      else XB_SPIN(xb_ld(&bar[XB_TOPGEN]) == tg, bar);
      __builtin_amdgcn_fence(__ATOMIC_ACQUIRE, "agent");
      xb_add(&bar[XB_XGEN(b.x)], 1u);
      asm volatile("s_waitcnt vmcnt(0)" ::: "memory");
    } else {
      XB_SPIN(xb_ld(&bar[XB_XGEN(b.x)]) == gen, bar);
      __builtin_amdgcn_fence(__ATOMIC_ACQUIRE, "agent");
      asm volatile("s_waitcnt vmcnt(0)" ::: "memory");
    }
  }
  __syncthreads();
}

constexpr int NPHASE = 1 + DEPTH * 10 + 1;
#ifndef ONLY
#define ONLY -1
#endif
#ifndef PROBE_MASK
#define PROBE_MASK 0x0
#endif
#ifndef PROBE_SYNC
#define PROBE_SYNC 0
#endif

__global__ void __launch_bounds__(256, 2) mega_kernel(Params p, int ph_lo, int ph_hi) {
  __shared__ __attribute__((aligned(16))) char smem[SMEM_BYTES + 16];
  cg::grid_group grid = cg::this_grid();
  volatile AS3 unsigned* xst = (volatile AS3 unsigned*)(smem + SMEM_BYTES);
  if (threadIdx.x == 0) { xst[0] = 0u; xst[1] = 0u; }
  __syncthreads();
  const XcdBarrier xb = xcd_barrier_post((unsigned*)(p.ws + OFF_BAR), xst);
  const int G = gridDim.x, bid = blockIdx.x;
  for (int ph = ph_lo; ph < ph_hi; ++ph) {
    if (ph == 0) {
      if (ONLY < 0 || ONLY == 10) { phase_init(p, smem); __syncthreads(); convert_layer(p, 0, smem); }
    } else if (ph == NPHASE - 1) {
      rows_phase(p, false, (const bf16_t*)(WS(p) + OFF_D), DEPTH - 1, 5, p.ln_gain + ((DEPTH - 1) * 2 + 1) * 1024,
                 p.ln_bias + ((DEPTH - 1) * 2 + 1) * 1024, 0, 0, nullptr);
    } else {
      const int l = (ph - 1) / 10, sp = (ph - 1) % 10;
      const int reps = ((PROBE_MASK >> sp) & 1) ? 2 : 1;
      for (int rep = 0; rep < reps; ++rep)
      switch (sp) {
        case 0: if (ONLY < 0 || ONLY == 0) {
          if (rep == 0) {
          if (l == 0) rows_phase(p, true, nullptr, 0, 0, nullptr, nullptr, 0, 0, (bf16_t*)(WS(p) + OFF_D));
          else rows_phase(p, false, (const bf16_t*)(WS(p) + OFF_D), l - 1, 5, p.ln_gain + ((l - 1) * 2 + 1) * 1024,
                          p.ln_bias + ((l - 1) * 2 + 1) * 1024, l, 0, (bf16_t*)(WS(p) + OFF_D));
          }
          if (l > 0) convert_layer(p, l, smem);
        } break;
        case 1: if (ONLY < 0 || ONLY == 1) {
          TileOrder to; to.init(MROWS / 128, NP / 128, bid & 7, 0);
          const int nslot = (G + 7 - (bid & 7)) >> 3;
          int i = bid >> 3, brow, pn, nm;
          if (i < to.total) { to.get(i, brow, pn, nm); __syncthreads(); gemm_prefetch0(job_win(p, brow >> 7, pn), smem); }
          for (; i < to.total; i += nslot) {
            to.get(i, brow, pn, nm);
            GemmJob nx{}; const bool hn = i + nslot < to.total;
            if (hn) { int b2, pn2, nm2; to.get(i + nslot, b2, pn2, nm2); nx = job_win(p, b2 >> 7, pn2); }
            tile_win(p, brow >> 7, pn, smem, nx, hn);
          }
        } break;
        case 2: if (ONLY < 0 || ONLY == 2) {
          constexpr int nM = MROWS / 128;
          constexpr int n_q = nM * 6, n_kv = nM * 8, n_r = 2 * 4 * NCHUNK;
          auto upjob = [&](int ti) { return ti < n_q ? job_up<true>(p, ti % nM, ti / nM) : job_up<false>(p, (ti - n_q) % nM, (ti - n_q) / nM); };
          if (bid < n_q + n_kv) { __syncthreads(); gemm_prefetch0(upjob(bid), smem); }
          for (int ti = bid; ti < n_q + n_kv + n_r; ti += G) {
            GemmJob nx{}; const bool hn = ti + G < n_q + n_kv;
            if (hn) nx = upjob(ti + G);
            if (ti < n_q) tile_up<true>(p, ti % nM, ti / nM, smem, nx, hn);
            else if (ti < n_q + n_kv) tile_up<false>(p, (ti - n_q) % nM, (ti - n_q) / nM, smem, nx, hn);
            else tile_retkv(p, l, ti - n_q - n_kv, smem);
          }
        } break;
        case 3: if (ONLY < 0 || ONLY == 3) {
          constexpr int n_s = 512;
          for (int ti = bid; ti < n_s; ti += G) { if (rep == 0) unit_scan(p, l, ti); }
          const int xcd = bid & 7, slot = bid >> 3, nslot = (G + 7 - xcd) >> 3;
          for (int k = 0; k < 2; ++k)
            for (int qt = slot; qt < 64; qt += nslot) tile_mla(p, (xcd + 8 * k) * 66 + qt, smem);
        } break;
        case 4: if (ONLY < 0 || ONLY == 4) {
          const int xcd = bid & 7;
          for (int ti = bid; ti < 2 * 4 * NCHUNK * 2; ti += G) tile_retout(p, l, ti, smem);
          if (rep == 0) {
            unsigned* qw = (unsigned*)(WS(p) + OFF_BAR) + l * 8 + xcd;
            volatile AS3 unsigned* tk = (volatile AS3 unsigned*)(smem + SMEM_BYTES + 12);
            for (;;) {
              __syncthreads();
              if (tidx() == 0) *tk = __hip_atomic_fetch_add(qw, 1u, __ATOMIC_RELAXED, __HIP_MEMORY_SCOPE_AGENT);
              __syncthreads();
              const unsigned t = *tk;
              if (t >= 128u) break;
              tile_na(p, l, (xcd + 8 * (int)(t >> 6)) * 66 + (int)(t & 63u), smem);
            }
          } else {
            const int slot = bid >> 3, nslot = (G + 7 - xcd) >> 3;
            for (int k = 0; k < 2; ++k)
              for (int qt = slot; qt < 64; qt += nslot) tile_na(p, l, (xcd + 8 * k) * 66 + qt, smem);
          }
          for (int i = (G - 1 - bid); i < 64; i += G) {
            if (i < 32) tile_na(p, l, (i >> 1) * 66 + 64 + (i & 1), smem);
            else tile_mla(p, ((i - 32) >> 1) * 66 + 64 + (i & 1), smem);
          }
        } break;
        case 5: if (ONLY < 0 || ONLY == 5) {
          TileOrder to; to.init(MROWS / 128, 8, bid & 7, 1);
          const int nslot = (G + 7 - (bid & 7)) >> 3;
          int i = bid >> 3, brow, pn, nm;
          if (i < to.total) { to.get(i, brow, pn, nm); __syncthreads(); gemm_prefetch0(job_merge(p, brow, pn, 0, nm), smem); }
          for (; i < to.total; i += nslot) {
            to.get(i, brow, pn, nm);
            GemmJob nx{}; const bool hn = i + nslot < to.total;
            if (hn) { int b2, pn2, nm2; to.get(i + nslot, b2, pn2, nm2); nx = job_merge(p, b2, pn2, 0, nm2); }
            if (nm == 4) tile_merge<4>(p, brow, pn, smem, nx, hn); else tile_merge<1>(p, brow, pn, smem, nx, hn);
          }
        } break;
        case 6: if (ONLY < 0 || ONLY == 6) {
          TileOrder to; to.init(MROWS / 128, 8, bid & 7, 1);
          const int nslot = (G + 7 - (bid & 7)) >> 3;
          const bf16_t* pa = (const bf16_t*)(WS(p) + OFF_E); const bf16_t* pw = (const bf16_t*)(WS(p) + OFF_WT + WT_OUT);
          bf16_t* po = (bf16_t*)(WS(p) + OFF_D);
          int i = bid >> 3, brow, pn, nm;
          if (i < to.total) { to.get(i, brow, pn, nm); __syncthreads(); gemm_prefetch0(job_plain(pa, 1024, pw, 1024, brow, pn, nm), smem); }
          for (; i < to.total; i += nslot) {
            to.get(i, brow, pn, nm);
            GemmJob nx{}; const bool hn = i + nslot < to.total;
            if (hn) { int b2, pn2, nm2; to.get(i + nslot, b2, pn2, nm2); nx = job_plain(pa, 1024, pw, 1024, b2, pn2, nm2); }
            if (nm == 4) tile_plain<0, 4>(pa, 1024, pw, 1024, po, 1024, brow, pn, smem, nx, hn);
            else tile_plain<0, 1>(pa, 1024, pw, 1024, po, 1024, brow, pn, smem, nx, hn);
          }
        } break;
        case 7: if (ONLY < 0 || ONLY == 7) {
          if (rep == 0) rows_phase(p, false, (const bf16_t*)(WS(p) + OFF_D), l, 2, p.ln_gain + (l * 2) * 1024, p.ln_bias + (l * 2) * 1024, l, 3,
                     (bf16_t*)(WS(p) + OFF_E));
        } break;
        case 8: if (ONLY < 0 || ONLY == 8) {
          TileOrder to; to.init(MROWS / 128, 32, bid & 7, 1);
          const int nslot = (G + 7 - (bid & 7)) >> 3;
          const bf16_t* pa = (const bf16_t*)(WS(p) + OFF_E); const bf16_t* pw = (const bf16_t*)(WS(p) + OFF_WT + WT_FF1);
          bf16_t* po = (bf16_t*)(WS(p) + OFF_P);
          int i = bid >> 3, brow, pn, nm;
          if (i < to.total) { to.get(i, brow, pn, nm); __syncthreads(); gemm_prefetch0(job_plain(pa, 1024, pw, 1024, brow, pn, nm), smem); }
          for (; i < to.total; i += nslot) {
            to.get(i, brow, pn, nm);
            GemmJob nx{}; const bool hn = i + nslot < to.total;
            if (hn) { int b2, pn2, nm2; to.get(i + nslot, b2, pn2, nm2); nx = job_plain(pa, 1024, pw, 1024, b2, pn2, nm2); }
            if (nm == 4) tile_plain<1, 4>(pa, 1024, pw, 1024, po, 4096, brow, pn, smem, nx, hn);
            else tile_plain<1, 1>(pa, 1024, pw, 1024, po, 4096, brow, pn, smem, nx, hn);
          }
        } break;
        case 9: if (ONLY < 0 || ONLY == 9) {
          TileOrder to; to.init(MROWS / 128, 8, bid & 7, 1);
          const int nslot = (G + 7 - (bid & 7)) >> 3;
          const bf16_t* pa = (const bf16_t*)(WS(p) + OFF_P); const bf16_t* pw = (const bf16_t*)(WS(p) + OFF_WT + WT_FF2);
          bf16_t* po = (bf16_t*)(WS(p) + OFF_D);
          int i = bid >> 3, brow, pn, nm;
          if (i < to.total) { to.get(i, brow, pn, nm); __syncthreads(); gemm_prefetch0(job_plain(pa, 4096, pw, 4096, brow, pn, nm), smem); }
          for (; i < to.total; i += nslot) {
            to.get(i, brow, pn, nm);
            GemmJob nx{}; const bool hn = i + nslot < to.total;
            if (hn) { int b2, pn2, nm2; to.get(i + nslot, b2, pn2, nm2); nx = job_plain(pa, 4096, pw, 4096, b2, pn2, nm2); }
            if (nm == 4) tile_plain<0, 4>(pa, 4096, pw, 4096, po, 1024, brow, pn, smem, nx, hn);
            else tile_plain<0, 1>(pa, 4096, pw, 4096, po, 1024, brow, pn, smem, nx, hn);
          }
        } break;
      }
    }
    if (ph + 1 < ph_hi) {
      if (ph_lo < 0) grid.sync();
      xcd_barrier(xb);
    }
  }
}

#ifndef ONE_LAUNCH
#define ONE_LAUNCH 1
#endif

extern "C" void kernel_launch(void* const* d_in, const int* in_sizes, int n_in, void* d_out, int out_size, void* d_ws, size_t ws_size,
                              hipStream_t stream) {
  static int grid_blocks = 0;
  if (!grid_blocks) {
    int dev = 0, cus = 0, per_cu = 0;
    hipGetDevice(&dev);
    hipDeviceGetAttribute(&cus, hipDeviceAttributeMultiprocessorCount, dev);
    hipOccupancyMaxActiveBlocksPerMultiprocessor(&per_cu, mega_kernel, 256, 0);
    if (per_cu > 2) per_cu = 2;
    grid_blocks = cus * per_cu;
  }
  if (ws_size < WS_NEED) { fprintf(stderr, "workspace too small: %zu < %zu\n", ws_size, (size_t)WS_NEED); return; }
  Params p{};
  const float** pp = (const float**)&p;
  for (int i = 0; i < 22; ++i) pp[i] = (const float*)d_in[i];
  p.out = (float*)d_out;
  p.ws = (char*)d_ws;
  hipMemsetAsync((char*)d_ws + OFF_BAR, 0, 16384, stream);
#if ONE_LAUNCH
  int lo = 0, hi = NPHASE;
  void* args[] = {&p, &lo, &hi};
  hipError_t e = hipLaunchCooperativeKernel((void*)mega_kernel, dim3(grid_blocks), dim3(256), args, 0, stream);
  if (e != hipSuccess) fprintf(stderr, "cooperative launch failed: %s (grid %d)\n", hipGetErrorString(e), grid_blocks);
#else
  for (int ph = 0; ph < NPHASE; ++ph) {
    int lo = ph, hi = ph + 1;
    void* args[] = {&p, &lo, &hi};
    hipError_t e = hipLaunchCooperativeKernel((void*)mega_kernel, dim3(grid_blocks), dim3(256), args, 0, stream);
    if (e != hipSuccess) fprintf(stderr, "launch failed: %s\n", hipGetErrorString(e));
  }
#endif
}
```
